# Optimizing an MI355X kernel written in HIP

```python
import math
import jax, jax.numpy as jnp
from jax import lax
import numpy as np


D_MODEL = 1024
BATCH = 16
SEQ = 2048
DEPTH = 1

D_MIX = D_MODEL
HEAD_DIM = 64
N_ATTN_HEADS = 8
N_KV_GROUPS = 2
HEADS_PER_GROUP = N_ATTN_HEADS // N_KV_GROUPS
D_ATTN = N_ATTN_HEADS * HEAD_DIM
D_KV = N_KV_GROUPS * HEAD_DIM
N_BRANCH = 3
D_CONV = D_MIX - D_ATTN
N_CONV_GROUPS = 8
CONV_WIDTH = 3
CMP_BLOCK = 32
CMP_STRIDE = 16
CMP_HIDDEN = 256
SEL_BLOCK = 64
SEL_TOPK = 16
N_LOCAL_FORCED = 2
WINDOW = 512
Q_CHUNK = 32
N_BUCKETS = 32
MAX_DISTANCE = 128
D_FF = -(-(8 * D_MODEL // 3) // 256) * 256
D_IN_PROJ = D_ATTN + 6 * D_KV + N_BRANCH * N_ATTN_HEADS + 3 * D_CONV
EPS = 1e-6
NEG_INF = -1e30
FORCED_SCORE = 1e6

kernel_name = "hybrid_nsa_shortconv_adaln_layer"


def rms_norm(x, gain):
    x32 = x.astype(jnp.float32)
    y = x32 * lax.rsqrt(jnp.mean(x32 * x32, axis=-1, keepdims=True) + EPS)
    return y.astype(x.dtype) * gain


def t5_bucket(rel):
    n = jnp.maximum(rel, 0)
    max_exact = N_BUCKETS // 2
    nf = jnp.maximum(n, 1).astype(jnp.float32)
    large = max_exact + (jnp.log(nf / max_exact) / math.log(MAX_DISTANCE / max_exact)
                         * (N_BUCKETS - max_exact)).astype(jnp.int32)
    return jnp.where(n < max_exact, n, jnp.minimum(large, N_BUCKETS - 1))


def head_bias(table, rel):
    b = table[t5_bucket(rel)]
    return jnp.moveaxis(b, -1, 0).reshape((N_KV_GROUPS, HEADS_PER_GROUP) + tuple(rel.shape))


def masked_softmax(logits, mask):
    logits = jnp.where(mask, logits.astype(jnp.float32), NEG_INF)
    p = jax.nn.softmax(logits, axis=-1)
    return p * jnp.any(mask, axis=-1, keepdims=True)


def nsa_mixer(q, k_c, v_c, k_s, v_s, k_w, v_w, gate_logits, q_gain, k_cmp_gain, k_sel_gain,
              k_win_gain, cmp_pos_k, cmp_pos_v, w_ck1, w_ck2, w_cv1, w_cv2, rel_bias_table):
    bsz, seq = q.shape[0], q.shape[1]
    G, HPG, DH = N_KV_GROUPS, HEADS_PER_GROUP, HEAD_DIM
    scale = DH ** -0.5
    t_pos = np.arange(seq)

    q = rms_norm(q.reshape(bsz, seq, G, HPG, DH), q_gain).transpose(0, 2, 3, 1, 4)

    def kv_heads(a):
        return a.reshape(bsz, seq, G, DH).transpose(0, 2, 1, 3)

    n_cmp = (seq - CMP_BLOCK) // CMP_STRIDE + 1
    cmp_start = np.arange(n_cmp) * CMP_STRIDE
    cmp_end = cmp_start + CMP_BLOCK - 1
    cmp_idx = cmp_start[:, None] + np.arange(CMP_BLOCK)[None, :]

    def compress(a, pos_emb, w1, w2):
        blocks = kv_heads(a)[:, :, cmp_idx] + pos_emb
        flat = blocks.reshape(bsz, G, n_cmp, CMP_BLOCK * DH)
        return jnp.dot(jax.nn.silu(jnp.dot(flat, w1)), w2)

    kc = rms_norm(compress(k_c, cmp_pos_k, w_ck1, w_ck2), k_cmp_gain)
    vc = compress(v_c, cmp_pos_v, w_cv1, w_cv2)
    rel_c = t_pos[:, None] - cmp_end[None, :]
    logits_c = jnp.einsum('bghsd,bgnd->bghsn', q, kc) * scale + head_bias(rel_bias_table, rel_c)
    p_c = masked_softmax(logits_c, jnp.asarray(rel_c >= 0))
    o_c = jnp.einsum('bghsn,bgnd->bghsd', p_c.astype(vc.dtype), vc)

    n_sel = seq // SEL_BLOCK
    top_k = min(SEL_TOPK, n_sel)
    sel_start = np.arange(n_sel) * SEL_BLOCK
    overlap = np.clip(np.minimum(cmp_end[:, None], sel_start[None, :] + SEL_BLOCK - 1)
                      - np.maximum(cmp_start[:, None], sel_start[None, :]) + 1, 0, None) / CMP_STRIDE
    p_slc = jnp.einsum('bghsn,nj->bgsj', p_c, jnp.asarray(overlap, jnp.float32))
    dist_blk = (t_pos // SEL_BLOCK)[:, None] - np.arange(n_sel)[None, :]
    valid = dist_blk >= 0
    forced = (np.arange(n_sel)[None, :] == 0) | (valid & (dist_blk < N_LOCAL_FORCED))
    score = jnp.where(valid, jnp.where(forced, FORCED_SCORE, p_slc), NEG_INF)
    sel_idx = lax.top_k(score, top_k)[1]

    k_blocks = rms_norm(kv_heads(k_s), k_sel_gain).reshape(bsz, G, n_sel, SEL_BLOCK, DH)
    v_blocks = kv_heads(v_s).reshape(bsz, G, n_sel, SEL_BLOCK, DH)
    tab_g = rel_bias_table.reshape(N_BUCKETS, G, HPG)
    b_ar = jnp.arange(bsz)[:, None, None, None]
    g_ar = jnp.arange(G)[None, :, None, None]
    n_tok = top_k * SEL_BLOCK

    pad = ((0, 0), (0, 0), (WINDOW, 0), (0, 0))
    kwin = jnp.pad(rms_norm(kv_heads(k_w), k_win_gain), pad)
    vwin = jnp.pad(kv_heads(v_w), pad)
    span = WINDOW + Q_CHUNK
    rel_w = WINDOW + np.arange(Q_CHUNK)[:, None] - np.arange(span)[None, :]
    bias_w = head_bias(rel_bias_table, rel_w)

    def chunk(ci):
        s0 = ci * Q_CHUNK
        t_q = s0 + jnp.arange(Q_CHUNK)
        qc = lax.dynamic_slice_in_dim(q, s0, Q_CHUNK, axis=3)
        idx = lax.dynamic_slice_in_dim(sel_idx, s0, Q_CHUNK, axis=2)
        kg = k_blocks[b_ar, g_ar, idx].reshape(bsz, G, Q_CHUNK, n_tok, DH)
        vg = v_blocks[b_ar, g_ar, idx].reshape(bsz, G, Q_CHUNK, n_tok, DH)
        key_pos = (idx[..., None] * SEL_BLOCK + jnp.arange(SEL_BLOCK)).reshape(bsz, G, Q_CHUNK, n_tok)
        rel_s = t_q[None, None, :, None] - key_pos
        bias_s = jnp.moveaxis(tab_g[t5_bucket(rel_s), g_ar], -1, 2)
        logits_s = jnp.einsum('bghqd,bgqkd->bghqk', qc, kg) * scale + bias_s
        p_s = masked_softmax(logits_s, (rel_s >= 0)[:, :, None])
        o_s = jnp.einsum('bghqk,bgqkd->bghqd', p_s.astype(vg.dtype), vg)
        kw = lax.dynamic_slice_in_dim(kwin, s0, span, axis=2)
        vw = lax.dynamic_slice_in_dim(vwin, s0, span, axis=2)
        key_pos_w = s0 - WINDOW + jnp.arange(span)
        rel = t_q[:, None] - key_pos_w[None, :]
        mask_w = (rel >= 0) & (rel < WINDOW) & (key_pos_w[None, :] >= 0)
        logits_w = jnp.einsum('bghqd,bgkd->bghqk', qc, kw) * scale + bias_w
        p_w = masked_softmax(logits_w, mask_w)
        o_w = jnp.einsum('bghqk,bgkd->bghqd', p_w.astype(vw.dtype), vw)
        return o_s, o_w

    o_s, o_w = lax.map(chunk, jnp.arange(seq // Q_CHUNK))

    def unchunk(o):
        return jnp.moveaxis(o, 0, 3).reshape(bsz, G, HPG, seq, DH)

    gates = jax.nn.sigmoid(gate_logits.reshape(bsz, seq, G, HPG, N_BRANCH)).transpose(0, 2, 3, 1, 4)
    o = gates[..., 0:1] * o_c + gates[..., 1:2] * unchunk(o_s) + gates[..., 2:3] * unchunk(o_w)
    return o.transpose(0, 3, 1, 2, 4).reshape(bsz, seq, D_ATTN)


def short_conv_mixer(b_gate, c_gate, xt, conv_w):
    seq = xt.shape[1]
    u = c_gate * xt
    u_pad = jnp.pad(u, ((0, 0), (CONV_WIDTH - 1, 0), (0, 0)))
    conv = sum(u_pad[:, k:k + seq] * conv_w[k] for k in range(CONV_WIDTH))
    return b_gate * conv


def swiglu(h, w1, w3, w2):
    return jnp.dot(jax.nn.silu(jnp.dot(h, w1)) * jnp.dot(h, w3), w2)


def setup_inputs(seed: int = 0) -> dict:
    key = jax.random.key(seed)
    ks = jax.random.split(key, 25)
    L = DEPTH

    def nrm(k, shape, s):
        return jax.random.normal(k, shape, jnp.float32) * s

    def gain(k, shape):
        return 1.0 + nrm(k, shape, 0.02)

    return {
        "x": nrm(ks[0], (BATCH, SEQ, D_MODEL), 1.0),
        "c": nrm(ks[1], (BATCH, D_MODEL), 1.0),
        "w_ada": nrm(ks[2], (L, D_MODEL, 6 * D_MODEL), 0.5 * D_MODEL ** -0.5),
        "b_ada": nrm(ks[3], (L, 6 * D_MODEL), 0.02),
        "norm1_gain": gain(ks[4], (L, D_MODEL)),
        "w_in": nrm(ks[5], (L, D_MODEL, D_IN_PROJ), D_MODEL ** -0.5),
        "q_gain": gain(ks[6], (L, HEAD_DIM)),
        "k_cmp_gain": gain(ks[7], (L, HEAD_DIM)),
        "k_sel_gain": gain(ks[8], (L, HEAD_DIM)),
        "k_win_gain": gain(ks[9], (L, HEAD_DIM)),
        "cmp_pos_k": nrm(ks[10], (L, CMP_BLOCK, HEAD_DIM), 0.1),
        "cmp_pos_v": nrm(ks[11], (L, CMP_BLOCK, HEAD_DIM), 0.1),
        "w_ck1": nrm(ks[12], (L, CMP_BLOCK * HEAD_DIM, CMP_HIDDEN), (CMP_BLOCK * HEAD_DIM) ** -0.5),
        "w_ck2": nrm(ks[13], (L, CMP_HIDDEN, HEAD_DIM), CMP_HIDDEN ** -0.5),
        "w_cv1": nrm(ks[14], (L, CMP_BLOCK * HEAD_DIM, CMP_HIDDEN), (CMP_BLOCK * HEAD_DIM) ** -0.5),
        "w_cv2": nrm(ks[15], (L, CMP_HIDDEN, HEAD_DIM), CMP_HIDDEN ** -0.5),
        "rel_bias_table": nrm(ks[16], (N_BUCKETS, N_ATTN_HEADS), 0.5),
        "conv_w": nrm(ks[17], (L, CONV_WIDTH, D_CONV), CONV_WIDTH ** -0.5),
        "attn_out_gain": gain(ks[18], (L, D_ATTN)),
        "conv_out_gain": gain(ks[19], (L, D_CONV)),
        "w_out": nrm(ks[20], (L, D_MIX, D_MODEL), D_MIX ** -0.5),
        "norm2_gain": gain(ks[21], (L, D_MODEL)),
        "w_ff1": nrm(ks[22], (L, D_MODEL, D_FF), D_MODEL ** -0.5),
        "w_ff3": nrm(ks[23], (L, D_MODEL, D_FF), D_MODEL ** -0.5),
        "w_ff2": nrm(ks[24], (L, D_FF, D_MODEL), D_FF ** -0.5),
    }


def reference(x, c, w_ada, b_ada, norm1_gain, w_in, q_gain, k_cmp_gain, k_sel_gain, k_win_gain,
              cmp_pos_k, cmp_pos_v, w_ck1, w_ck2, w_cv1, w_cv2, rel_bias_table, conv_w,
              attn_out_gain, conv_out_gain, w_out, norm2_gain, w_ff1, w_ff3, w_ff2):
    split_points = np.cumsum([D_ATTN] + [D_KV] * 6 + [N_BRANCH * N_ATTN_HEADS] + [D_CONV] * 3)[:-1].tolist()
    for layer in range(DEPTH):
        mod = jnp.dot(jax.nn.silu(c), w_ada[layer]) + b_ada[layer]
        shift1, scale1, gate1, shift2, scale2, gate2 = jnp.split(mod[:, None, :], 6, axis=-1)

        h = rms_norm(x, norm1_gain[layer]) * (1 + scale1) + shift1
        proj = jnp.dot(h, w_in[layer])
        q, k_c, v_c, k_s, v_s, k_w, v_w, gate_logits, b_gate, c_gate, xt = jnp.split(proj, split_points, axis=-1)
        y_attn = nsa_mixer(q, k_c, v_c, k_s, v_s, k_w, v_w, gate_logits, q_gain[layer],
                           k_cmp_gain[layer], k_sel_gain[layer], k_win_gain[layer],
                           cmp_pos_k[layer], cmp_pos_v[layer], w_ck1[layer], w_ck2[layer],
                           w_cv1[layer], w_cv2[layer], rel_bias_table)
        y_conv = short_conv_mixer(b_gate, c_gate, xt, conv_w[layer])
        y = jnp.concatenate([rms_norm(y_attn, attn_out_gain[layer]),
                             rms_norm(y_conv, conv_out_gain[layer])], axis=-1)
        x = x + gate1 * jnp.dot(y, w_out[layer])

        h2 = rms_norm(x, norm2_gain[layer]) * (1 + scale2) + shift2
        x = x + gate2 * swiglu(h2, w_ff1[layer], w_ff3[layer], w_ff2[layer])
    return x
```

```cpp
#include <hip/hip_runtime.h>
#include <cstdio>
#include <cstdint>

constexpr int DM = 1024, NB = 16, SEQ = 2048, MTOK = NB * SEQ, HD = 64, NH = 8;
constexpr int NPROJ = 2840, DFF = 2816, NCMP = 127;
constexpr float EPSF = 1e-6f;

typedef _Float16 h16;
typedef _Float16 h16x4 __attribute__((ext_vector_type(4)));
typedef _Float16 h16x8 __attribute__((ext_vector_type(8)));
typedef __bf16 bf16x8_t __attribute__((ext_vector_type(8)));

constexpr size_t MiB = 1u << 20;
constexpr size_t WS_CTL = 0;
constexpr size_t WS_MOD = 1 * MiB;
constexpr size_t WS_BIAS13 = 1 * MiB + 512 * 1024;
constexpr size_t WS_SSQ2 = 2 * MiB;
constexpr size_t WS_KCNH = 4 * MiB;
constexpr size_t WS_KCNL = 4 * MiB + 512 * 1024;
constexpr size_t WS_VCC = 5 * MiB;
constexpr size_t WS_GATES = 6 * MiB;
constexpr size_t WS_A1H = 40 * MiB, WS_A1L = 104 * MiB;
constexpr size_t WS_QH = 168 * MiB, WS_QL = 200 * MiB;
constexpr size_t WS_KCH = 232 * MiB, WS_KCL = 240 * MiB, WS_VC = 248 * MiB, WS_KS = 256 * MiB, WS_VS = 264 * MiB, WS_KW = 272 * MiB, WS_VW = 280 * MiB;
constexpr size_t WS_BCX = 292 * MiB;
constexpr size_t WS_Y = 40 * MiB;
constexpr size_t WS_A2 = 232 * MiB;
constexpr size_t WS_U = 296 * MiB;
constexpr size_t WS_X1H = 168 * MiB;
constexpr size_t WS_END = 472 * MiB;

struct Params {
    const float *x, *c, *w_ada, *b_ada, *norm1_gain, *w_in, *q_gain, *k_cmp_gain, *k_sel_gain, *k_win_gain, *cmp_pos_k, *cmp_pos_v,
        *w_ck1, *w_ck2, *w_cv1, *w_cv2, *rel_bias, *conv_w, *attn_out_gain, *conv_out_gain, *w_out, *norm2_gain, *w_ff1, *w_ff3, *w_ff2;
    float* out;
    unsigned char* ws;
};

#define DEVI __device__ __forceinline__

DEVI float wsum(float v) {
#pragma unroll
    for (int o = 32; o > 0; o >>= 1) v += __shfl_xor(v, o);
    return v;
}
DEVI float wmax(float v) {
#pragma unroll
    for (int o = 32; o > 0; o >>= 1) v = fmaxf(v, __shfl_xor(v, o));
    return v;
}
DEVI float siluf(float v) { return v / (1.f + expf(-v)); }
DEVI float sigmf(float v) { return 1.f / (1.f + expf(-v)); }
DEVI float sigm_fast(float v) { return __builtin_amdgcn_rcpf(1.f + __builtin_amdgcn_exp2f(-1.4426950408889634f * v)); }
DEVI float silu_fast(float v) { return v * sigm_fast(v); }
DEVI int t5_bucket(int n) {
    if (n < 16) return n;
    int large = 16 + (int)(logf((float)n / 16.f) / 2.0794415416798357f * 16.f);
    return large < 31 ? large : 31;
}

namespace fg {
#define FG_LAS __attribute__((address_space(3)))
typedef float f32x4 __attribute__((ext_vector_type(4)));
typedef unsigned u32x4 __attribute__((ext_vector_type(4)));
typedef unsigned u32x2 __attribute__((ext_vector_type(2)));
constexpr int BM = 256, BK = 64, HALF = 128, HTB = HALF * BK * 2, STAGE_BYTES = 8 * HTB, NXCD = 8, WGM = 8;
__host__ __device__ __forceinline__ int lds_byte(int r, int c) { const int st = (r >> 4) * 2 + (c >> 5), rr = r & 15, cc = c & 31, ob = rr * 64 + cc * 2; return st * 1024 + (ob ^ (((ob >> 9) & 1) << 5)); }
__host__ __device__ __forceinline__ void stage_rc(int b, int& R, int& C) { const int st = b / 1024, sb = b % 1024, swz = sb ^ (((sb >> 9) & 1) << 5); R = (st >> 1) * 16 + swz / 64; C = (st & 1) * 32 + (swz % 64) / 2; }
__host__ __device__ __forceinline__ int perm32(int rho) { const int n = rho >> 4, i = rho & 15; return 8 * (i >> 2) + 4 * n + (i & 3); }
struct Unit { int pm, pn; };
struct Gemm {
    const h16* A; const h16* A2; const h16* Bt; int M, N, K, lda; size_t hstepA; int ldb;
    DEVI const char* a_tile(const Unit& u) const { return A2 ? (const char*)((u.pn & 1) ? A2 : A) + (size_t)u.pm * 2 * hstepA + (size_t)(u.pn >> 1) * K * 2 : (const char*)A + (size_t)u.pm * 2 * hstepA; }
    DEVI const char* b_tile(const Unit& u) const { return A2 ? (const char*)Bt + (size_t)(u.pn & 1) * 2 * HALF * ldb * 2 + (size_t)(u.pn >> 1) * K * 2 : (const char*)Bt + (size_t)u.pn * 2 * HALF * ldb * 2; }
};
struct StaticOrder {
    int nM, nN, nwg, G, c;
    __host__ __device__ void init(int M, int N, int G_, int c_) { nM = M / BM; nN = N / BM; nwg = nM * nN; G = G_; c = c_; }
    __host__ __device__ bool next(int i, Unit& u) const {
        const long L = (long)i * G + c; if (L >= nwg) return false;
        int wgid = (int)L; { const int q = nwg / NXCD, r = nwg % NXCD, xcd = wgid % NXCD, off = wgid / NXCD; wgid = (xcd < r ? xcd * (q + 1) : r * (q + 1) + (xcd - r) * q) + off; }
        const int nig = WGM * nN, gid = wgid / nig, fm = gid * WGM, gsz = (nM - fm) < WGM ? (nM - fm) : WGM;
        u.pm = fm + ((wgid % nig) % gsz); u.pn = (wgid % nig) / gsz; return true;
    }
};
#ifndef FG_ALIGN
#define FG_ALIGN true
#endif
#ifndef FG_SP2
#define FG_SP2 true
#endif
template <class Epi, bool ALIGN_EPI = FG_ALIGN, bool SP2 = FG_SP2>
DEVI void gemm_phase(FG_LAS unsigned char* lds, const Gemm g, const StaticOrder& S, const Epi& E) {
    const int tid = threadIdx.x, wid = __builtin_amdgcn_readfirstlane(tid >> 6), lane = tid & 63, wr = wid >> 2, wc = wid & 3, fr = lane & 15, fq = lane >> 4;
    const int K = g.K, nt = K / BK;
    unsigned voffA[2], voffB[2];
#pragma unroll
    for (int i = 0; i < 2; ++i) { int R, C; stage_rc(tid * 16 + i * 8192, R, C); const int Rb = Epi::PERM ? ((R & ~31) + perm32(R & 31)) : R;
        voffA[i] = (unsigned)(R * g.lda + C) * 2u; voffB[i] = (unsigned)(Rb * g.ldb + C) * 2u; }
    const size_t kstep = (size_t)(BK * 2);
    const size_t hstepA = g.hstepA, hstepB = (size_t)HALF * g.ldb * 2;
    const unsigned ldsw = (unsigned)wid * 1024u;
    const int aoff = lds_byte(wr * 64 + fr, fq * 8), boff = lds_byte(wc * 32 + fr, fq * 8);
#define FG_SA(b, h) (((b) * 2 + (h)) * HTB)
#define FG_SB(b, h) ((4 + (b) * 2 + (h)) * HTB)
#define FG_STAGE(bufoff, gbase, voff) do { _Pragma("unroll") for (int _i = 0; _i < 2; ++_i) \
        __builtin_amdgcn_global_load_lds((const unsigned*)((const char*)(gbase) + (voff)[_i]), (FG_LAS unsigned*)(lds + (bufoff) + ldsw + _i * 8192), 16, 0, 0); } while (0)
#define FG_LDA(dst, b, h) do { _Pragma("unroll") for (int m = 0; m < 4; ++m) _Pragma("unroll") for (int k = 0; k < 2; ++k) dst[m][k] = *(const FG_LAS h16x8*)(lds + FG_SA(b, h) + aoff + m * 2048 + k * 1024); } while (0)
#define FG_LDB(dst, b, h) do { _Pragma("unroll") for (int n = 0; n < 2; ++n) _Pragma("unroll") for (int k = 0; k < 2; ++k) dst[n][k] = *(const FG_LAS h16x8*)(lds + FG_SB(b, h) + boff + n * 2048 + k * 1024); } while (0)
#define FG_MMA(ai, bj, At, Bt) do { __builtin_amdgcn_s_setprio(1); _Pragma("unroll") for (int m = 0; m < 4; ++m) _Pragma("unroll") for (int n = 0; n < 2; ++n) _Pragma("unroll") for (int k = 0; k < 2; ++k) \
        acc[ai][bj][m][n] = __builtin_amdgcn_mfma_f32_16x16x32_f16(Bt[n][k], At[m][k], acc[ai][bj][m][n], 0, 0, 0); __builtin_amdgcn_s_setprio(0); } while (0)
#define FG_WAIT_V(n) asm volatile("s_waitcnt vmcnt(" #n ")" ::: "memory")
#define FG_WAIT_L(n) asm volatile("s_waitcnt lgkmcnt(" #n ")" ::: "memory")
#define FG_BAR __builtin_amdgcn_s_barrier()
#define FG_SCHED __builtin_amdgcn_sched_barrier(0)
    Unit cur, nxt; int ui = 0;
    if (!S.next(0, cur)) return;
    f32x4 acc[2][2][4][2];
#pragma unroll
    for (int a = 0; a < 2; ++a)
#pragma unroll
        for (int b = 0; b < 2; ++b)
#pragma unroll
            for (int m = 0; m < 4; ++m)
#pragma unroll
                for (int n = 0; n < 2; ++n) acc[a][b][m][n] = (f32x4){0.f, 0.f, 0.f, 0.f};
    h16x8 At[4][2], B0[2][2], B1[2][2];
    const char* cA = g.a_tile(cur); const char* cB = g.b_tile(cur);
    if constexpr (SP2) {
        FG_STAGE(FG_SB(0, 0), cB, voffB); FG_STAGE(FG_SB(0, 1), cB + hstepB, voffB); FG_STAGE(FG_SA(0, 0), cA, voffA); FG_STAGE(FG_SA(0, 1), cA + hstepA, voffA);
        if (wr == 1) FG_BAR;
        FG_WAIT_V(2); FG_BAR;
        FG_STAGE(FG_SB(1, 0), cB + kstep, voffB); FG_STAGE(FG_SA(1, 0), cA + kstep, voffA); FG_STAGE(FG_SB(1, 1), cB + hstepB + kstep, voffB);
        FG_WAIT_V(6); FG_BAR;
    } else {
        FG_STAGE(FG_SB(0, 0), cB, voffB); FG_STAGE(FG_SA(0, 0), cA, voffA); FG_STAGE(FG_SB(0, 1), cB + hstepB, voffB); FG_STAGE(FG_SA(0, 1), cA + hstepA, voffA);
        if (wr == 1) FG_BAR;
        FG_WAIT_V(4); FG_BAR;
        FG_STAGE(FG_SB(1, 0), cB + kstep, voffB); FG_STAGE(FG_SA(1, 0), cA + kstep, voffA); FG_STAGE(FG_SB(1, 1), cB + hstepB + kstep, voffB);
        FG_WAIT_V(6); FG_BAR;
    }
    for (;;) {
        const bool has_next = S.next(ui + 1, nxt);
        const char* nA = has_next ? g.a_tile(nxt) : cA; const char* nB = has_next ? g.b_tile(nxt) : cB;
        for (int t = 0; t < nt; t += 2) {
            const bool last = (t == nt - 2);
            const char* a1 = cA + (size_t)(t + 1) * kstep;
            const char* a2 = last ? nA : cA + (size_t)(t + 2) * kstep; const char* b2 = last ? nB : cB + (size_t)(t + 2) * kstep;
            const char* a3 = a2 + kstep; const char* b3 = b2 + kstep;
            if constexpr (SP2) {
            FG_LDB(B0, 0, 0); FG_LDB(B1, 0, 1); FG_SCHED; FG_LDA(At, 0, 0); FG_STAGE(FG_SA(1, 1), a1 + hstepA, voffA);
            FG_WAIT_V(8); FG_WAIT_L(0); FG_BAR; FG_MMA(0, 0, At, B0); FG_MMA(0, 1, At, B1); FG_BAR; FG_SCHED;
            FG_LDA(At, 0, 1); FG_STAGE(FG_SB(0, 0), b2, voffB); FG_STAGE(FG_SB(0, 1), b2 + hstepB, voffB); FG_STAGE(FG_SA(0, 0), a2, voffA);
            FG_WAIT_V(8); FG_WAIT_L(0); FG_BAR; FG_MMA(1, 0, At, B0); FG_MMA(1, 1, At, B1); FG_BAR; FG_SCHED;
            FG_LDB(B0, 1, 0); FG_LDB(B1, 1, 1); FG_SCHED; FG_LDA(At, 1, 0); FG_STAGE(FG_SA(0, 1), a2 + hstepA, voffA);
            FG_WAIT_V(8); FG_WAIT_L(0); FG_BAR; FG_MMA(0, 0, At, B0); FG_MMA(0, 1, At, B1); FG_BAR; FG_SCHED;
            FG_LDA(At, 1, 1); FG_STAGE(FG_SB(1, 0), b3, voffB); FG_STAGE(FG_SB(1, 1), b3 + hstepB, voffB); FG_STAGE(FG_SA(1, 0), a3, voffA);
            FG_WAIT_V(8); FG_WAIT_L(0); FG_BAR; FG_MMA(1, 0, At, B0); FG_MMA(1, 1, At, B1); FG_BAR; FG_SCHED;
            } else {
            FG_LDB(B0, 0, 0); FG_SCHED; FG_LDA(At, 0, 0); FG_STAGE(FG_SA(1, 1), a1 + hstepA, voffA);
            FG_WAIT_L(8); FG_BAR; FG_WAIT_L(0); FG_MMA(0, 0, At, B0); FG_BAR; FG_SCHED;
            FG_LDB(B1, 0, 1); FG_STAGE(FG_SB(0, 0), b2, voffB);
            FG_BAR; FG_WAIT_L(0); FG_MMA(0, 1, At, B1); FG_BAR;
            FG_LDA(At, 0, 1); FG_STAGE(FG_SA(0, 0), a2, voffA);
            FG_BAR; FG_WAIT_L(0); FG_MMA(1, 0, At, B0); FG_BAR; FG_SCHED;
            FG_STAGE(FG_SB(0, 1), b2 + hstepB, voffB);
            FG_WAIT_V(6); FG_BAR; FG_MMA(1, 1, At, B1); FG_BAR;
            FG_LDB(B0, 1, 0); FG_SCHED; FG_LDA(At, 1, 0); FG_STAGE(FG_SA(0, 1), a2 + hstepA, voffA);
            FG_WAIT_L(8); FG_BAR; FG_WAIT_L(0); FG_MMA(0, 0, At, B0); FG_BAR; FG_SCHED;
            FG_LDB(B1, 1, 1); FG_STAGE(FG_SB(1, 0), b3, voffB);
            FG_BAR; FG_WAIT_L(0); FG_MMA(0, 1, At, B1); FG_BAR;
            FG_LDA(At, 1, 1); FG_STAGE(FG_SA(1, 0), a3, voffA);
            FG_BAR; FG_WAIT_L(0); FG_MMA(1, 0, At, B0); FG_BAR; FG_SCHED;
            FG_STAGE(FG_SB(1, 1), b3 + hstepB, voffB);
            FG_WAIT_V(6); FG_BAR; FG_MMA(1, 1, At, B1); FG_BAR;
            }
        }
        if constexpr (ALIGN_EPI) { if (wr == 0) FG_BAR; }
        E(acc, cur, wr, wc, fr, fq);
        if (!has_next) break;
#pragma unroll
        for (int a = 0; a < 2; ++a)
#pragma unroll
            for (int b = 0; b < 2; ++b)
#pragma unroll
                for (int m = 0; m < 4; ++m)
#pragma unroll
                    for (int n = 0; n < 2; ++n) acc[a][b][m][n] = (f32x4){0.f, 0.f, 0.f, 0.f};
        cur = nxt; cA = nA; cB = nB; ++ui;
        if constexpr (ALIGN_EPI) { if (wr == 1) FG_BAR; }
    }
    FG_WAIT_V(0);
    if constexpr (!ALIGN_EPI) { if (wr == 0) FG_BAR; }
    FG_BAR;
#undef FG_SA
#undef FG_SB
#undef FG_STAGE
#undef FG_LDA
#undef FG_LDB
#undef FG_MMA
#undef FG_WAIT_V
#undef FG_WAIT_L
#undef FG_BAR
#undef FG_SCHED
}
}

constexpr size_t WS_WIN = 10 * MiB;
constexpr size_t WS_WOUT = 16 * MiB;
constexpr size_t WS_W13 = 18 * MiB;
constexpr size_t WS_W2 = 29 * MiB;
constexpr size_t WS_WC1 = 35 * MiB;
constexpr size_t WS_POSB = 9 * MiB;
constexpr size_t WS_HID = 104 * MiB;

DEVI int inproj_src(int nrow) {
    const int pn = nrow >> 8, tc = nrow & 255;
    if (pn < 5) { const int gi = 4 * pn + ((tc & 127) >> 5), d = 32 * (tc >> 7) + (tc & 31); return 64 * gi + d; }
    if (pn < 11) return 1304 + 256 * (pn - 5) + tc;
    return tc < 24 ? 1280 + tc : -1;
}
template <class SRC>
DEVI void transpose_item(const SRC& src, int K, h16* WT, float* scr, int item, int nblk, int lane) {
    const int kb = item / nblk, nb = item % nblk, k0 = 64 * kb, n0 = 32 * nb;
    float tv[32];
#pragma unroll
    for (int i = 0; i < 32; ++i) tv[i] = src(k0 + 2 * i + (lane >> 5), n0 + (lane & 31));
#pragma unroll
    for (int i = 0; i < 32; ++i) scr[(2 * i + (lane >> 5)) * 33 + (lane & 31)] = tv[i];
    asm volatile("s_waitcnt lgkmcnt(0)" ::: "memory");
    const int c = lane & 7;
#pragma unroll
    for (int j = 0; j < 4; ++j) { const int n = (lane >> 3) + 8 * j; const float* s = scr + (8 * c) * 33 + n;
        h16x8 o;
#pragma unroll
        for (int q = 0; q < 8; ++q) o[q] = (h16)s[q * 33];
        *(h16x8*)(WT + (size_t)(n0 + n) * K + k0 + 8 * c) = o; }
    asm volatile("s_waitcnt lgkmcnt(0)" ::: "memory");
}
struct SrcWin { const float* W; DEVI float operator()(int k, int n) const { const int s = inproj_src(n); return s < 0 ? 0.f : W[(size_t)k * NPROJ + s]; } };
struct SrcWout { const float *W, *ga, *gc; DEVI float operator()(int k, int n) const { return W[(size_t)k * 1024 + n] * (k < 512 ? ga[k] : gc[k - 512]); } };
struct SrcW13 { const float *W1, *W3; DEVI float operator()(int k, int n) const { const int pn = n >> 8, tc = n & 255; return tc < 128 ? W1[(size_t)k * DFF + 128 * pn + tc] : W3[(size_t)k * DFF + 128 * pn + tc - 128]; } };
struct SrcW2 { const float* W; DEVI float operator()(int k, int n) const { return W[(size_t)k * 1024 + n]; } };
struct SrcWc1 { const float *Wk, *Wv; DEVI float operator()(int k, int n) const { return n < 256 ? Wk[(size_t)k * 256 + n] : Wv[(size_t)k * 256 + n - 256]; } };
struct EF_ffn2 {
    static constexpr bool PERM = true;
    const Params* P;
    DEVI void operator()(const fg::f32x4 (&acc)[2][2][4][2], const fg::Unit& u, int wr, int wc, int fr, int fq) const {
        const Params& p = *P;
        const float* mod = (const float*)(p.ws + WS_MOD);
        const h16* X1 = (const h16*)(p.ws + WS_X1H);
        const int b = (u.pm * 256) >> 11;
#pragma unroll
        for (int bj = 0; bj < 2; ++bj) {
            const int col = u.pn * 256 + 128 * bj + 32 * wc + 8 * fq;
            h16x8 xv[2][4];
#pragma unroll
            for (int ai = 0; ai < 2; ++ai)
#pragma unroll
                for (int m = 0; m < 4; ++m) xv[ai][m] = *(const h16x8*)(X1 + (size_t)(u.pm * 256 + 128 * ai + 64 * wr + 16 * m + fr) * 1024 + col);
            fg::f32x4 g2[2];
#pragma unroll
            for (int n = 0; n < 2; ++n) g2[n] = *(const fg::f32x4*)(mod + b * 6144 + 5120 + col + 4 * n);
#pragma unroll
            for (int ai = 0; ai < 2; ++ai)
#pragma unroll
                for (int m = 0; m < 4; ++m) {
                    float* op = p.out + (size_t)(u.pm * 256 + 128 * ai + 64 * wr + 16 * m + fr) * 1024 + col;
#pragma unroll
                    for (int n = 0; n < 2; ++n) {
                        fg::f32x4 o;
#pragma unroll
                        for (int i = 0; i < 4; ++i) o[i] = (float)xv[ai][m][4 * n + i] + g2[n][i] * acc[ai][bj][m][n][i];
                        *(fg::f32x4*)(op + 4 * n) = o;
                    }
                }
        }
    }
};
DEVI void ph_ffn2_fast(const Params& P, unsigned char* lds_raw) {
    fg::Gemm g{(const h16*)(P.ws + WS_U), nullptr, (const h16*)(P.ws + WS_W2), MTOK, 1024, DFF, DFF, (size_t)128 * DFF * 2, DFF};
    fg::StaticOrder S; S.init(MTOK, 1024, gridDim.x, blockIdx.x);
    EF_ffn2 E{&P};
    fg::gemm_phase<EF_ffn2>((FG_LAS unsigned char*)lds_raw, g, S, E);
}

struct EF_ffn1 {
    static constexpr bool PERM = true;
    const Params* P;
    DEVI void operator()(const fg::f32x4 (&acc)[2][2][4][2], const fg::Unit& u, int wr, int wc, int fr, int fq) const {
        const Params& p = *P;
        const float* bias13 = (const float*)(p.ws + WS_BIAS13);
        const float* SSQ = (const float*)(p.ws + WS_SSQ2);
        h16* U = (h16*)(p.ws + WS_U);
        const int b = (u.pm * 256) >> 11, col = 128 * u.pn + 32 * wc + 8 * fq;
        fg::f32x4 sq[2][4];
#pragma unroll
        for (int ai = 0; ai < 2; ++ai)
#pragma unroll
            for (int m = 0; m < 4; ++m) sq[ai][m] = *(const fg::f32x4*)(SSQ + (size_t)(u.pm * 256 + 128 * ai + 64 * wr + 16 * m + fr) * 16 + 4 * fq);
        fg::f32x4 b1[2], b3[2];
#pragma unroll
        for (int n = 0; n < 2; ++n) { b1[n] = *(const fg::f32x4*)(bias13 + b * 5632 + col + 4 * n); b3[n] = *(const fg::f32x4*)(bias13 + b * 5632 + 2816 + col + 4 * n); }
        float rstd[2][4];
#pragma unroll
        for (int ai = 0; ai < 2; ++ai)
#pragma unroll
            for (int m = 0; m < 4; ++m) {
                float s = (sq[ai][m][0] + sq[ai][m][1]) + (sq[ai][m][2] + sq[ai][m][3]);
                s += __shfl_xor(s, 16); s += __shfl_xor(s, 32);
                rstd[ai][m] = rsqrtf(s * (1.f / 1024.f) + EPSF);
            }
#pragma unroll
        for (int ai = 0; ai < 2; ++ai)
#pragma unroll
            for (int m = 0; m < 4; ++m) {
                const int row = u.pm * 256 + 128 * ai + 64 * wr + 16 * m + fr;
                h16x8 o;
#pragma unroll
                for (int n = 0; n < 2; ++n)
#pragma unroll
                    for (int i = 0; i < 4; ++i) {
                        const float a = rstd[ai][m] * acc[ai][0][m][n][i] + b1[n][i];
                        const float c = rstd[ai][m] * acc[ai][1][m][n][i] + b3[n][i];
                        o[4 * n + i] = (h16)(silu_fast(a) * c);
                    }
                *(h16x8*)(U + (size_t)row * DFF + col) = o;
            }
    }
};
DEVI void ph_ffn1_fast(const Params& P, unsigned char* lds_raw) {
    fg::Gemm g{(const h16*)(P.ws + WS_A2), nullptr, (const h16*)(P.ws + WS_W13), MTOK, 5632, 1024, 1024, (size_t)128 * 1024 * 2, 1024};
    fg::StaticOrder S; S.init(MTOK, 5632, gridDim.x, blockIdx.x);
    EF_ffn1 E{&P};
    fg::gemm_phase<EF_ffn1>((FG_LAS unsigned char*)lds_raw, g, S, E);
}

struct EF_outproj {
    static constexpr bool PERM = true;
    const Params* P;
    DEVI void operator()(const fg::f32x4 (&acc)[2][2][4][2], const fg::Unit& u, int wr, int wc, int fr, int fq) const {
        const Params& p = *P;
        const float* mod = (const float*)(p.ws + WS_MOD);
        h16* A2 = (h16*)(p.ws + WS_A2);
        h16* X1 = (h16*)(p.ws + WS_X1H);
        float* SSQ = (float*)(p.ws + WS_SSQ2);
        const int b = (u.pm * 256) >> 11;
        float ss[2][4];
#pragma unroll
        for (int ai = 0; ai < 2; ++ai)
#pragma unroll
            for (int m = 0; m < 4; ++m) ss[ai][m] = 0.f;
#pragma unroll
        for (int bj = 0; bj < 2; ++bj) {
            const int col = u.pn * 256 + 128 * bj + 32 * wc + 8 * fq;
            fg::f32x4 g1[2], gs[2];
#pragma unroll
            for (int n = 0; n < 2; ++n) {
                g1[n] = *(const fg::f32x4*)(mod + b * 6144 + 2048 + col + 4 * n);
                const fg::f32x4 s2 = *(const fg::f32x4*)(mod + b * 6144 + 4096 + col + 4 * n), n2 = *(const fg::f32x4*)(p.norm2_gain + col + 4 * n);
                gs[n] = n2 * (s2 + 1.f);
            }
#pragma unroll
            for (int ai = 0; ai < 2; ++ai) {
                fg::f32x4 xv[4][2];
#pragma unroll
                for (int m = 0; m < 4; ++m) { const float* xp = p.x + (size_t)(u.pm * 256 + 128 * ai + 64 * wr + 16 * m + fr) * 1024 + col; xv[m][0] = *(const fg::f32x4*)xp; xv[m][1] = *(const fg::f32x4*)(xp + 4); }
#pragma unroll
                for (int m = 0; m < 4; ++m) {
                    const int row = u.pm * 256 + 128 * ai + 64 * wr + 16 * m + fr;
                    h16x8 xh, ah;
#pragma unroll
                    for (int n = 0; n < 2; ++n) {
                        const fg::f32x4 x1 = xv[m][n] + g1[n] * acc[ai][bj][m][n];
                        const fg::f32x4 a = x1 * gs[n];
#pragma unroll
                        for (int i = 0; i < 4; ++i) { xh[4 * n + i] = (h16)x1[i]; ah[4 * n + i] = (h16)a[i]; }
                        ss[ai][m] += (x1[0] * x1[0] + x1[1] * x1[1]) + (x1[2] * x1[2] + x1[3] * x1[3]);
                    }
                    *(h16x8*)(X1 + (size_t)row * 1024 + col) = xh;
                    *(h16x8*)(A2 + (size_t)row * 1024 + col) = ah;
                }
            }
        }
#pragma unroll
        for (int ai = 0; ai < 2; ++ai)
#pragma unroll
            for (int m = 0; m < 4; ++m) {
                float s = ss[ai][m];
                s += __shfl_xor(s, 16); s += __shfl_xor(s, 32);
                if (fq == 0) SSQ[(size_t)(u.pm * 256 + 128 * ai + 64 * wr + 16 * m + fr) * 16 + u.pn * 4 + wc] = s;
            }
    }
};
DEVI void ph_outproj_fast(const Params& P, unsigned char* lds_raw) {
    fg::Gemm g{(const h16*)(P.ws + WS_Y), nullptr, (const h16*)(P.ws + WS_WOUT), MTOK, 1024, 1024, 1024, (size_t)128 * 1024 * 2, 1024};
    fg::StaticOrder S; S.init(MTOK, 1024, gridDim.x, blockIdx.x);
    EF_outproj E{&P};
    fg::gemm_phase<EF_outproj>((FG_LAS unsigned char*)lds_raw, g, S, E);
}

struct EF_inproj {
    static constexpr bool PERM = true;
    const Params* P;
    DEVI void operator()(const fg::f32x4 (&acc)[2][2][4][2], const fg::Unit& u, int wr, int wc, int fr, int fq) const {
        const Params& p = *P;
        const int pn = u.pn;
        if (pn < 5) {
            const int gi = 4 * pn + wc;
            const int kind = gi < 8 ? 0 : 1 + ((gi - 8) >> 1), g = gi & 1;
            const bool normed = (kind == 0 || kind == 3 || kind == 5);
            const float qsc = kind == 0 ? 0.125f * 1.4426950408889634f : 1.f;
            const float* gn = kind == 0 ? p.q_gain : kind == 3 ? p.k_sel_gain : p.k_win_gain;
            fg::f32x4 gv[2][2];
#pragma unroll
            for (int bj = 0; bj < 2; ++bj)
#pragma unroll
                for (int n = 0; n < 2; ++n) gv[bj][n] = normed ? *(const fg::f32x4*)(gn + 32 * bj + 8 * fq + 4 * n) : (fg::f32x4){1.f, 1.f, 1.f, 1.f};
            h16* base = (h16*)(p.ws + (kind == 0 ? WS_QH : kind == 1 ? WS_KCH : kind == 2 ? WS_VC : kind == 3 ? WS_KS : kind == 4 ? WS_VS : kind == 5 ? WS_KW : WS_VW));
#pragma unroll
            for (int ai = 0; ai < 2; ++ai)
#pragma unroll
                for (int m = 0; m < 4; ++m) {
                    const int row = u.pm * 256 + 128 * ai + 64 * wr + 16 * m + fr;
                    float ss = 0.f;
#pragma unroll
                    for (int bj = 0; bj < 2; ++bj)
#pragma unroll
                        for (int n = 0; n < 2; ++n) { const fg::f32x4 v = acc[ai][bj][m][n]; ss += (v[0] * v[0] + v[1] * v[1]) + (v[2] * v[2] + v[3] * v[3]); }
                    ss += __shfl_xor(ss, 16); ss += __shfl_xor(ss, 32);
                    const float rstd = normed ? rsqrtf(ss * (1.f / 64.f) + EPSF) : 1.f;
                    h16* dst = kind == 0 ? base + (size_t)row * 512 + gi * 64 : base + ((size_t)((row >> 11) * 2 + g) * 2048 + (row & 2047)) * 64;
#pragma unroll
                    for (int bj = 0; bj < 2; ++bj) {
                        h16x8 o;
                        if (kind == 4 || kind == 6) {
                            bf16x8_t ob;
#pragma unroll
                            for (int n = 0; n < 2; ++n)
#pragma unroll
                                for (int i = 0; i < 4; ++i) ob[4 * n + i] = (__bf16)acc[ai][bj][m][n][i];
                            o = __builtin_bit_cast(h16x8, ob);
                        } else {
#pragma unroll
                            for (int n = 0; n < 2; ++n)
#pragma unroll
                                for (int i = 0; i < 4; ++i) o[4 * n + i] = (h16)(acc[ai][bj][m][n][i] * (rstd * qsc) * gv[bj][n][i]);
                        }
                        *(h16x8*)(dst + 32 * bj + 8 * fq) = o;
                    }
                }
        } else if (pn < 11) {
            h16* BCX = (h16*)(p.ws + WS_BCX);
#pragma unroll
            for (int ai = 0; ai < 2; ++ai)
#pragma unroll
                for (int m = 0; m < 4; ++m) {
                    const int row = u.pm * 256 + 128 * ai + 64 * wr + 16 * m + fr;
#pragma unroll
                    for (int bj = 0; bj < 2; ++bj) {
                        h16x8 o;
#pragma unroll
                        for (int n = 0; n < 2; ++n)
#pragma unroll
                            for (int i = 0; i < 4; ++i) o[4 * n + i] = (h16)acc[ai][bj][m][n][i];
                        *(h16x8*)(BCX + (size_t)row * 1536 + 256 * (pn - 5) + 128 * bj + 32 * wc + 8 * fq) = o;
                    }
                }
        } else {
            if (wc == 0 && fq < 3) {
                float* GA = (float*)(p.ws + WS_GATES);
#pragma unroll
                for (int ai = 0; ai < 2; ++ai)
#pragma unroll
                    for (int m = 0; m < 4; ++m) {
                        const int row = u.pm * 256 + 128 * ai + 64 * wr + 16 * m + fr;
#pragma unroll
                        for (int n = 0; n < 2; ++n) *(fg::f32x4*)(GA + (size_t)row * 24 + 8 * fq + 4 * n) = acc[ai][0][m][n];
                    }
            }
        }
    }
};
DEVI void ph_inproj_fast(const Params& P, unsigned char* lds_raw) {
    fg::Gemm g{(const h16*)(P.ws + WS_A1H), nullptr, (const h16*)(P.ws + WS_WIN), MTOK, 3072, 1024, 1024, (size_t)128 * 1024 * 2, 1024};
    fg::StaticOrder S; S.init(MTOK, 3072, gridDim.x, blockIdx.x);
    EF_inproj E{&P};
    fg::gemm_phase<EF_inproj>((FG_LAS unsigned char*)lds_raw, g, S, E);
}

constexpr size_t WS_SH2H = 140 * MiB;
constexpr size_t WS_HIDP = 104 * MiB;
struct EF_compress {
    static constexpr bool PERM = false;
    const Params* P;
    DEVI void operator()(const fg::f32x4 (&acc)[2][2][4][2], const fg::Unit& u, int wr, int wc, int fr, int fq) const {
        const Params& p = *P;
        float* HID = (float*)(p.ws + WS_HIDP) + (size_t)(u.pn >> 1) * 4096 * 512 + 256 * (u.pn & 1);
#pragma unroll
        for (int bj = 0; bj < 2; ++bj)
#pragma unroll
            for (int n = 0; n < 2; ++n) {
                const int col = 128 * bj + 32 * wc + 16 * n + 4 * fq;
#pragma unroll
                for (int ai = 0; ai < 2; ++ai)
#pragma unroll
                    for (int m = 0; m < 4; ++m) {
                        const int row = u.pm * 256 + 128 * ai + 64 * wr + 16 * m + fr;
                        *(fg::f32x4*)(HID + (size_t)row * 512 + col) = acc[ai][bj][m][n];
                    }
            }
    }
};
DEVI void ph_compress_fast(const Params& P, unsigned char* lds_raw) {
    fg::Gemm g{(const h16*)(P.ws + WS_KCH), (const h16*)(P.ws + WS_VC), (const h16*)(P.ws + WS_WC1), 4096, 2048, 512, 1024, (size_t)2048 * 64 * 2, 2048};
    fg::StaticOrder S; S.init(4096, 2048, gridDim.x, blockIdx.x);
    EF_compress E{&P};
    fg::gemm_phase<EF_compress>((FG_LAS unsigned char*)lds_raw, g, S, E);
}
struct EF_bias13 {
    static constexpr bool PERM = true;
    const Params* P;
    DEVI void operator()(const fg::f32x4 (&acc)[2][2][4][2], const fg::Unit& u, int wr, int wc, int fr, int fq) const {
        if (wr != 0) return;
        float* bias13 = (float*)(P->ws + WS_BIAS13) + fr * 5632 + 128 * u.pn + 32 * wc + 8 * fq;
#pragma unroll
        for (int n = 0; n < 2; ++n) { *(fg::f32x4*)(bias13 + 4 * n) = acc[0][0][0][n]; *(fg::f32x4*)(bias13 + 2816 + 4 * n) = acc[0][1][0][n]; }
    }
};
DEVI void ph_bias13_gemm(const Params& P, unsigned char* lds_raw) {
    fg::Gemm g{(const h16*)(P.ws + WS_SH2H), nullptr, (const h16*)(P.ws + WS_W13), 256, 5632, 1024, 1024, (size_t)128 * 1024 * 2, 1024};
    const bool wide = gridDim.x >= 150;
    const int G = wide ? 22 : (int)gridDim.x, c = wide ? (int)blockIdx.x - 128 : (int)blockIdx.x;
    if (c < 0 || c >= G) return;
    fg::StaticOrder S; S.init(256, 5632, G, c);
    EF_bias13 E{&P};
    fg::gemm_phase<EF_bias13>((FG_LAS unsigned char*)lds_raw, g, S, E);
}
constexpr size_t WS_MODP = 37 * MiB;
constexpr size_t WS_POSBP = 9 * MiB + 64 * 1024;
DEVI void fma16(float (&acc)[16], const float* s, float w) {
    const float4 s0 = *(const float4*)(s), s1 = *(const float4*)(s + 4), s2 = *(const float4*)(s + 8), s3 = *(const float4*)(s + 12);
    acc[0] += s0.x * w; acc[1] += s0.y * w; acc[2] += s0.z * w; acc[3] += s0.w * w; acc[4] += s1.x * w; acc[5] += s1.y * w; acc[6] += s1.z * w; acc[7] += s1.w * w;
    acc[8] += s2.x * w; acc[9] += s2.y * w; acc[10] += s2.z * w; acc[11] += s2.w * w; acc[12] += s3.x * w; acc[13] += s3.y * w; acc[14] += s3.z * w; acc[15] += s3.w * w;
}
DEVI void ph_prep2(const Params& P, float* lds) {
    const int tid = threadIdx.x, blk = blockIdx.x;
    if (blk < 96) {
        const int ks = blk & 7, jc = blk >> 3;
        float* sT = lds;
        for (int i = tid; i < 2048; i += 512) { const int kk = i >> 4, b = i & 15; sT[i] = siluf(P.c[b * 1024 + ks * 128 + kk]); }
        __syncthreads();
        const int j = jc * 512 + tid;
        float acc[16];
#pragma unroll
        for (int b = 0; b < 16; ++b) acc[b] = 0.f;
        const float* w = P.w_ada + (size_t)(ks * 128) * 6144 + j;
#pragma unroll 1
        for (int k0 = 0; k0 < 128; k0 += 16) {
            float wv32[16];
#pragma unroll
            for (int kk = 0; kk < 16; ++kk) wv32[kk] = w[(size_t)(k0 + kk) * 6144];
#pragma unroll
            for (int kk = 0; kk < 16; ++kk) { fma16(acc, sT + (k0 + kk) * 16, wv32[kk]); if ((kk & 3) == 3) __builtin_amdgcn_sched_barrier(0); }
        }
        float* modp = (float*)(P.ws + WS_MODP);
#pragma unroll
        for (int b = 0; b < 16; ++b) modp[(size_t)(ks * 16 + b) * 6144 + j] = acc[b];
        __syncthreads();
    } else if (blk < 112) {
        const int ks = blk - 96, which = tid >> 8, j = tid & 255;
        const float* w1 = (which ? P.w_cv1 : P.w_ck1) + (size_t)(ks * 128) * 256 + j;
        const float* pos = (which ? P.cmp_pos_v : P.cmp_pos_k) + ks * 128;
        float acc = 0.f;
#pragma unroll 1
        for (int k0 = 0; k0 < 128; k0 += 16) {
            float wv32[16];
#pragma unroll
            for (int kk = 0; kk < 16; ++kk) wv32[kk] = w1[(size_t)(k0 + kk) * 256];
#pragma unroll
            for (int kk = 0; kk < 16; ++kk) acc += pos[k0 + kk] * wv32[kk];
        }
        ((float*)(P.ws + WS_POSBP))[ks * 512 + tid] = acc;
    }
    const int lane = tid & 63, wv = tid >> 6, gw = blockIdx.x * 8 + wv, GW = gridDim.x * 8;
    float* scr = lds + wv * 4096;
    constexpr int I_IN = 16 * 96, I_OUT = 16 * 32, I_13 = 16 * 176, I_2 = 44 * 32, I_C = 32 * 16, NIT = I_IN + I_OUT + I_13 + I_2 + I_C;
    for (int it = gw; it < NIT; it += GW) {
        int r = it;
        if (r < I_IN) { transpose_item(SrcWin{P.w_in}, 1024, (h16*)(P.ws + WS_WIN), scr, r, 96, lane); continue; } r -= I_IN;
        if (r < I_OUT) { transpose_item(SrcWout{P.w_out, P.attn_out_gain, P.conv_out_gain}, 1024, (h16*)(P.ws + WS_WOUT), scr, r, 32, lane); continue; } r -= I_OUT;
        if (r < I_13) { transpose_item(SrcW13{P.w_ff1, P.w_ff3}, 1024, (h16*)(P.ws + WS_W13), scr, r, 176, lane); continue; } r -= I_13;
        if (r < I_2) { transpose_item(SrcW2{P.w_ff2}, DFF, (h16*)(P.ws + WS_W2), scr, r, 32, lane); continue; } r -= I_2;
        transpose_item(SrcWc1{P.w_ck1, P.w_cv1}, 2048, (h16*)(P.ws + WS_WC1), scr, r, 16, lane);
    }
}
DEVI void ph_norm1_2(const Params& P, float* lds) {
    const int tid = threadIdx.x, lane = tid & 63, wv = tid >> 6, blk = blockIdx.x;
    const float* modp = (const float*)(P.ws + WS_MODP);
    float* mod = (float*)(P.ws + WS_MOD);
    h16* A1H = (h16*)(P.ws + WS_A1H);
    for (int rg = blk; rg < 256; rg += gridDim.x) {
        const int b = rg >> 4, sl = rg & 15;
        float* ms = lds;
        for (int i = tid; i < 2048; i += 512) { float v = P.b_ada[i];
#pragma unroll
            for (int ks = 0; ks < 8; ++ks) v += modp[(size_t)(ks * 16 + b) * 6144 + i];
            ms[i] = v; }
        if (tid < 384) { const int j = sl * 384 + tid; float v = P.b_ada[j];
#pragma unroll
            for (int ks = 0; ks < 8; ++ks) v += modp[(size_t)(ks * 16 + b) * 6144 + j];
            mod[b * 6144 + j] = v;
            if (j >= 3072 && j < 4096) ((h16*)(P.ws + WS_SH2H))[b * 1024 + j - 3072] = (h16)v; }
        __syncthreads();
        for (int r = wv * 16; r < wv * 16 + 16; r += 8) {
            float4 v[8][4];
#pragma unroll
            for (int rr = 0; rr < 8; ++rr) { const float* xr = P.x + (size_t)(rg * 128 + r + rr) * 1024;
#pragma unroll
                for (int j = 0; j < 4; ++j) { const fg::f32x4 t = __builtin_nontemporal_load((const fg::f32x4*)(xr + 256 * j + 4 * lane)); v[rr][j] = make_float4(t[0], t[1], t[2], t[3]); } }
#pragma unroll
            for (int rr = 0; rr < 8; ++rr) {
                const int row = rg * 128 + r + rr;
                float s = 0.f;
#pragma unroll
                for (int j = 0; j < 4; ++j) s += v[rr][j].x * v[rr][j].x + v[rr][j].y * v[rr][j].y + v[rr][j].z * v[rr][j].z + v[rr][j].w * v[rr][j].w;
                const float rstd = rsqrtf(wsum(s) * (1.f / 1024.f) + EPSF);
#pragma unroll
                for (int j = 0; j < 4; ++j) {
                    const int k = 256 * j + 4 * lane;
                    const float4 g = *(const float4*)(P.norm1_gain + k);
                    const float4 sh = *(const float4*)(ms + k);
                    const float4 sc = *(const float4*)(ms + 1024 + k);
                    h16x4 hi;
                    hi[0] = (h16)(v[rr][j].x * rstd * g.x * (1.f + sc.x) + sh.x);
                    hi[1] = (h16)(v[rr][j].y * rstd * g.y * (1.f + sc.y) + sh.y);
                    hi[2] = (h16)(v[rr][j].z * rstd * g.z * (1.f + sc.z) + sh.z);
                    hi[3] = (h16)(v[rr][j].w * rstd * g.w * (1.f + sc.w) + sh.w);
                    *(h16x4*)(A1H + (size_t)row * 1024 + k) = hi;
                }
            }
        }
        __syncthreads();
    }
    if (blk == 88) {
        const float* pp = (const float*)(P.ws + WS_POSBP);
        float v = 0.f;
#pragma unroll
        for (int ks = 0; ks < 16; ++ks) v += pp[ks * 512 + tid];
        ((float*)(P.ws + WS_POSB))[tid] = v;
    }
}
constexpr int CW_CONVQ = 64;
DEVI void ph_conv2(const Params& P, float* lds) {
    const int lane = threadIdx.x & 63, wv = threadIdx.x >> 6;
    const h16* BCX = (const h16*)(P.ws + WS_BCX);
    h16* Y = (h16*)(P.ws + WS_Y);
    unsigned* ticket = (unsigned*)(P.ws + WS_CTL) + CW_CONVQ;
    volatile unsigned* slot = (volatile unsigned*)lds;
    const int c = lane * 8;
    float cw[3][8];
#pragma unroll
    for (int k = 0; k < 3; ++k)
#pragma unroll
        for (int i = 0; i < 8; ++i) cw[k][i] = P.conv_w[k * 512 + c + i];
    for (;;) {
        __syncthreads();
        if (threadIdx.x == 0) slot[0] = __hip_atomic_fetch_add(ticket, 1u, __ATOMIC_RELAXED, __HIP_MEMORY_SCOPE_AGENT);
        __syncthreads();
        const unsigned chunk = slot[0];
        if (chunk >= MTOK / 64) break;
        const int rowb = chunk * 64 + wv * 8, tb = rowb & 2047;
        const h16* rb = BCX + (size_t)rowb * 1536;
        float um1[8], um2[8];
        {
            h16x8 ca = {}, xa = {}, cb = {}, xb = {};
            if (tb >= 1) { ca = *(const h16x8*)(rb - 1536 + 512 + c); xa = *(const h16x8*)(rb - 1536 + 1024 + c); }
            if (tb >= 2) { cb = *(const h16x8*)(rb - 3072 + 512 + c); xb = *(const h16x8*)(rb - 3072 + 1024 + c); }
#pragma unroll
            for (int i = 0; i < 8; ++i) { um1[i] = (float)ca[i] * (float)xa[i]; um2[i] = (float)cb[i] * (float)xb[i]; }
        }
#pragma unroll
        for (int half = 0; half < 2; ++half) {
            h16x8 bgv[4], cv[4], xv[4];
#pragma unroll
            for (int j = 0; j < 4; ++j) { const h16* r2 = rb + (size_t)(half * 4 + j) * 1536; bgv[j] = *(const h16x8*)(r2 + c); cv[j] = *(const h16x8*)(r2 + 512 + c); xv[j] = *(const h16x8*)(r2 + 1024 + c); }
#pragma unroll
            for (int j = 0; j < 4; ++j) {
                float y[8], ssq = 0.f;
#pragma unroll
                for (int i = 0; i < 8; ++i) {
                    const float u0 = (float)cv[j][i] * (float)xv[j][i];
                    y[i] = (float)bgv[j][i] * (um2[i] * cw[0][i] + um1[i] * cw[1][i] + u0 * cw[2][i]);
                    um2[i] = um1[i]; um1[i] = u0;
                    ssq += y[i] * y[i];
                }
                const float rstd = rsqrtf(wsum(ssq) * (1.f / 512.f) + EPSF);
                h16x8 o;
#pragma unroll
                for (int i = 0; i < 8; ++i) o[i] = (h16)(y[i] * rstd);
                *(h16x8*)(Y + (size_t)(rowb + half * 4 + j) * 1024 + 512 + c) = o;
            }
        }
    }
}
DEVI void ph_compress2b(const Params& P, float* lds) {
    const int tid = threadIdx.x, lane = tid & 63, wv = tid >> 6;
    const int which = blockIdx.x & 1, nbw = (gridDim.x + 1 - which) >> 1, bw = blockIdx.x >> 1;
    const float* w2 = which ? P.w_cv2 : P.w_ck2;
    for (int i = tid; i < 4096; i += 512) *(float4*)(lds + 4 * i) = *(const float4*)(w2 + 4 * i);
    __syncthreads();
    const float* HID = (const float*)(P.ws + WS_HIDP);
    const float* posb = (const float*)(P.ws + WS_POSB);
    h16* dst = (h16*)(P.ws + (which ? WS_VCC : WS_KCNH));
    const float gain = P.k_cmp_gain[lane];
    for (int r = bw * 8 + wv; r < 4096; r += nbw * 8) {
        float o = 0.f;
        if ((r & 127) < 127) {
            float4 h4 = *(const float4*)(posb + 256 * which + 4 * lane);
#pragma unroll
            for (int ks = 0; ks < 4; ++ks) { const float4 t = *(const float4*)(HID + (size_t)ks * 4096 * 512 + (size_t)r * 512 + 256 * which + 4 * lane); h4.x += t.x; h4.y += t.y; h4.z += t.z; h4.w += t.w; }
            h4.x = silu_fast(h4.x); h4.y = silu_fast(h4.y); h4.z = silu_fast(h4.z); h4.w = silu_fast(h4.w);
#pragma unroll
            for (int jj = 0; jj < 64; ++jj) {
                o += __builtin_bit_cast(float, __builtin_amdgcn_readlane(__builtin_bit_cast(int, h4.x), jj)) * lds[(4 * jj + 0) * 64 + lane];
                o += __builtin_bit_cast(float, __builtin_amdgcn_readlane(__builtin_bit_cast(int, h4.y), jj)) * lds[(4 * jj + 1) * 64 + lane];
                o += __builtin_bit_cast(float, __builtin_amdgcn_readlane(__builtin_bit_cast(int, h4.z), jj)) * lds[(4 * jj + 2) * 64 + lane];
                o += __builtin_bit_cast(float, __builtin_amdgcn_readlane(__builtin_bit_cast(int, h4.w), jj)) * lds[(4 * jj + 3) * 64 + lane];
            }
            if (which == 0) o = o * rsqrtf(wsum(o * o) * (1.f / 64.f) + EPSF) * gain;
        }
        if (which) { const __bf16 ob = (__bf16)o; dst[(size_t)r * 64 + lane] = __builtin_bit_cast(h16, ob); } else dst[(size_t)r * 64 + lane] = (h16)o;
    }
}

namespace fa {
#define FA_LAS __attribute__((address_space(3)))
typedef float f32x16 __attribute__((ext_vector_type(16)));
typedef short s16x4 __attribute__((ext_vector_type(4)));
typedef short s16x8 __attribute__((ext_vector_type(8)));
constexpr float LOG2E = 1.4426950408889634f, NEGBIG = -30000.f, THR = 8.f;
constexpr int STAGE_B = 32768, L_BIAS = 65536, L_OT = 69632  , L_SLAB = 69632,
              L_SELM = 135168, L_SSQ = 135424, L_CB = 141568, OST_PITCH = 1040;

struct TileSrc { const h16 *k0, *k1, *v0, *v1; };
struct WaveCtx { int hi; int koff[4]; int voff; int dk, dv; FA_LAS const float* brow; };
DEVI void tile_dma(const TileSrc& S, int key0, FA_LAS unsigned char* st, const WaveCtx& W, int wv) {
    const size_t ko = (size_t)key0 * 64 + W.dk, vo = (size_t)key0 * 64 + W.dv;
    __builtin_amdgcn_global_load_lds((const unsigned*)(S.k0 + ko), (FA_LAS unsigned*)(st + wv * 1024), 16, 0, 0);
    __builtin_amdgcn_global_load_lds((const unsigned*)(S.k1 + ko), (FA_LAS unsigned*)(st + 8192 + wv * 1024), 16, 0, 0);
    __builtin_amdgcn_global_load_lds((const unsigned*)(S.v0 + vo), (FA_LAS unsigned*)(st + 16384 + wv * 1024), 16, 0, 0);
    __builtin_amdgcn_global_load_lds((const unsigned*)(S.v1 + vo), (FA_LAS unsigned*)(st + 24576 + wv * 1024), 16, 0, 0);
}
DEVI float max3f(float a, float b, float c) { float r; asm("v_max3_f32 %0, %1, %2, %3" : "=v"(r) : "v"(a), "v"(b), "v"(c)); return r; }

template <bool LOOKUP, bool EMASK, int RELMUL, int PSB>
DEVI void tile_step(FA_LAS const unsigned char* Kt, FA_LAS const unsigned char* Vt, const WaveCtx& W, const h16x8 (&qf)[4], f32x16 (&O)[2], float& mhat, float& lsum,
                    float cinit, int relb, int klo, int khi, f32x16& pA, f32x16& pB) {
    f32x16 p0, p1;
    {
        h16x8 kf[8];
#pragma unroll
        for (int s = 0; s < 4; ++s) { kf[2 * s] = *(FA_LAS const h16x8*)(Kt + W.koff[s]); kf[2 * s + 1] = *(FA_LAS const h16x8*)(Kt + 4096 + W.koff[s]); }
#pragma unroll
        for (int r = 0; r < 16; ++r) { p0[r] = cinit; p1[r] = cinit; }
        __builtin_amdgcn_sched_barrier(0);
        __builtin_amdgcn_s_setprio(1);
        p0 = __builtin_amdgcn_mfma_f32_32x32x16_f16(kf[0], qf[0], p0, 0, 0, 0);
        p1 = __builtin_amdgcn_mfma_f32_32x32x16_f16(kf[1], qf[0], p1, 0, 0, 0);
#pragma unroll
        for (int s = 1; s < 4; ++s) {
            p0 = __builtin_amdgcn_mfma_f32_32x32x16_f16(kf[2 * s], qf[s], p0, 0, 0, 0);
            p1 = __builtin_amdgcn_mfma_f32_32x32x16_f16(kf[2 * s + 1], qf[s], p1, 0, 0, 0);
        }
        __builtin_amdgcn_s_setprio(0);
    }
    const unsigned vb = (unsigned)(uintptr_t)Vt + (unsigned)W.voff;
    s16x4 vlo[8], vhi[8];
#pragma unroll
    for (int i = 0; i < 8; ++i) {
        asm volatile("ds_read_b64_tr_b16 %0, %1 offset:%c2" : "=&v"(vlo[i]) : "v"(vb), "i"((i >> 2) * 4096 + ((i >> 1) & 1) * 2048 + (i & 1) * 256) : "memory");
        asm volatile("ds_read_b64_tr_b16 %0, %1 offset:%c2" : "=&v"(vhi[i]) : "v"(vb), "i"((i >> 2) * 4096 + ((i >> 1) & 1) * 2048 + (i & 1) * 256 + 1024) : "memory");
    }
    if (LOOKUP) {
        const int relh = relb - RELMUL * 4 * W.hi;
#pragma unroll
        for (int r = 0; r < 16; ++r) {
            const int kc = (r & 3) + 8 * (r >> 2);
            int i0 = relh - RELMUL * kc;
            i0 = i0 < 0 ? 0 : (i0 > 127 ? 127 : i0);
            p0[r] += W.brow[i0];
        }
        __builtin_amdgcn_sched_barrier(0);
#pragma unroll
        for (int r = 0; r < 16; ++r) {
            const int kc = (r & 3) + 8 * (r >> 2);
            int i1 = relh - RELMUL * (kc + 32);
            i1 = i1 < 0 ? 0 : (i1 > 127 ? 127 : i1);
            p1[r] += W.brow[i1];
        }
    }
    if (EMASK) {
        const int kl = klo - 4 * W.hi, kh = khi - 4 * W.hi;
#pragma unroll
        for (int r = 0; r < 16; ++r) {
            const int kc = (r & 3) + 8 * (r >> 2);
            p0[r] = (kc >= kl && kc <= kh) ? p0[r] : NEGBIG;
            p1[r] = (kc + 32 >= kl && kc + 32 <= kh) ? p1[r] : NEGBIG;
        }
    }
    float sacc = 0.f, sacc1 = 0.f;
#pragma unroll
    for (int r = 0; r < 16; ++r) { p0[r] = __builtin_amdgcn_exp2f(p0[r]); p1[r] = __builtin_amdgcn_exp2f(p1[r]); sacc += p0[r]; asm("" : "+v"(sacc)); sacc1 += p1[r]; asm("" : "+v"(sacc1)); }
    lsum += sacc + sacc1;
    if (PSB >= 0) {
#pragma unroll
        for (int g4 = 0; g4 < 4; ++g4) {
            pA[PSB + g4] += 2.f * (p0[4 * g4] + p0[4 * g4 + 1] + p0[4 * g4 + 2]) + p0[4 * g4 + 3]; pB[PSB + g4] += p0[4 * g4 + 3];
            pA[PSB + 4 + g4] += 2.f * (p1[4 * g4] + p1[4 * g4 + 1] + p1[4 * g4 + 2]) + p1[4 * g4 + 3]; pB[PSB + 4 + g4] += p1[4 * g4 + 3];
        }
    }
    bf16x8_t pk[4];
#pragma unroll
    for (int kk = 0; kk < 4; ++kk)
#pragma unroll
        for (int j = 0; j < 8; ++j) pk[kk][j] = (__bf16)((kk >> 1) ? p1[8 * (kk & 1) + j] : p0[8 * (kk & 1) + j]);
    asm volatile("s_waitcnt lgkmcnt(0)" : "+v"(vlo[0]), "+v"(vhi[0]), "+v"(vlo[1]), "+v"(vhi[1]), "+v"(vlo[2]), "+v"(vhi[2]), "+v"(vlo[3]), "+v"(vhi[3]),
                 "+v"(vlo[4]), "+v"(vhi[4]), "+v"(vlo[5]), "+v"(vhi[5]), "+v"(vlo[6]), "+v"(vhi[6]), "+v"(vlo[7]), "+v"(vhi[7]) :: "memory");
    __builtin_amdgcn_sched_barrier(0);
    __builtin_amdgcn_s_setprio(1);
#pragma unroll
    for (int i = 0; i < 8; ++i) {
        const s16x8 v8 = {vlo[i][0], vlo[i][1], vlo[i][2], vlo[i][3], vhi[i][0], vhi[i][1], vhi[i][2], vhi[i][3]};
        O[i & 1] = __builtin_amdgcn_mfma_f32_32x32x16_bf16(__builtin_bit_cast(bf16x8_t, v8), pk[i >> 1], O[i & 1], 0, 0, 0);
    }
    __builtin_amdgcn_s_setprio(0);
}

DEVI unsigned wave_or(unsigned v) {
#pragma unroll
    for (int o = 1; o < 64; o <<= 1) v |= (unsigned)__shfl_xor((int)v, o);
    return v;
}

template <int MODE>
DEVI void branch_loop(unsigned tmask, const TileSrc& S, FA_LAS unsigned char* lds, const WaveCtx& W, const h16x8 (&qf)[4], f32x16 (&O)[2], float& mhat, float& lsum,
                      int g, int wv, int tq, int bt, int jlo, unsigned lmask, unsigned gunion) {
    f32x16 dA, dB;
    int jb = __builtin_ctz(tmask); tmask &= tmask - 1;
    tile_dma(S, 64 * jb, lds, W, wv);
    __syncthreads();
    int cur = 0;
    const float b31 = W.brow[127];
#pragma unroll 1
    for (;;) {
        const int nj = tmask ? __builtin_ctz(tmask) : -1;
        if (nj >= 0) { tmask &= tmask - 1; tile_dma(S, 64 * nj, lds + (cur ^ 1) * STAGE_B, W, wv); }
        FA_LAS const unsigned char* st = lds + cur * STAGE_B;
        FA_LAS const unsigned char* Kt = st + g * 8192;
        FA_LAS const unsigned char* Vt = st + 16384 + g * 8192;
        const bool lookup = (jb + 2 >= bt);
        const int relb = tq - 64 * jb;
        if (MODE == 1) {
            if ((gunion >> jb) & 1u) {
                const bool sel = (lmask >> jb) & 1u;
                if (jb == bt) tile_step<true, true, 1, -1>(Kt, Vt, W, qf, O, mhat, lsum, sel ? -mhat : NEGBIG, relb, -1000, relb, dA, dB);
                else if (lookup) tile_step<true, false, 1, -1>(Kt, Vt, W, qf, O, mhat, lsum, sel ? -mhat : NEGBIG, relb, 0, 0, dA, dB);
                else tile_step<false, false, 1, -1>(Kt, Vt, W, qf, O, mhat, lsum, sel ? b31 - mhat : NEGBIG, relb, 0, 0, dA, dB);
            }
        } else {
            const bool emask = (jb == bt) || (jb == jlo);
            if (lookup) {
                if (emask) tile_step<true, true, 1, -1>(Kt, Vt, W, qf, O, mhat, lsum, -mhat, relb, relb - 511, relb, dA, dB);
                else tile_step<true, false, 1, -1>(Kt, Vt, W, qf, O, mhat, lsum, -mhat, relb, 0, 0, dA, dB);
            } else {
                if (emask) tile_step<false, true, 1, -1>(Kt, Vt, W, qf, O, mhat, lsum, b31 - mhat, relb, relb - 511, relb, dA, dB);
                else tile_step<false, false, 1, -1>(Kt, Vt, W, qf, O, mhat, lsum, b31 - mhat, relb, 0, 0, dA, dB);
            }
        }
        __syncthreads();
        if (nj < 0) break;
        jb = nj; cur ^= 1;
    }
}

DEVI void attn_unit(const Params& P, FA_LAS unsigned char* lds, int b, int qt) {
    const int tid = threadIdx.x, lane = tid & 63, wv = __builtin_amdgcn_readfirstlane(tid >> 6), hi = lane >> 5, q = lane & 31, g = wv >> 2;
    const int q0 = 32 * qt, bt = q0 >> 6, tq = q0 + q, row0 = b * 2048 + q0;
    WaveCtx W; W.hi = hi;
    { const int x = (q >> 1) & 7;
#pragma unroll
      for (int s = 0; s < 4; ++s) W.koff[s] = q * 128 + (((2 * s + hi) ^ x) * 16); }
    W.voff = hi * 512 + ((lane >> 4) & 1) * 128 + ((lane & 15) >> 2) * 32 + (lane & 3) * 8;
    W.dk = (8 * wv + (lane >> 3)) * 64 + (((lane & 7) ^ ((4 * wv + (lane >> 4)) & 7)) * 8);
    W.dv = (8 * wv + 4 * (lane >> 5) + ((lane & 7) >> 1)) * 64 + ((lane >> 3) & 3) * 16 + (lane & 1) * 8;
    W.brow = (FA_LAS const float*)(lds + L_BIAS) + wv * 128;
    FA_LAS float* OtL = (FA_LAS float*)(lds + L_OT) + wv * 2048 + lane;
    const h16* QH = (const h16*)(P.ws + WS_QH);
    h16x8 qf[4];
#pragma unroll
    for (int s = 0; s < 4; ++s) qf[s] = *(const h16x8*)(QH + (size_t)(row0 + q) * 512 + wv * 64 + 16 * s + 8 * hi);
    FA_LAS float* gts = (FA_LAS float*)(lds + L_SSQ + 1024) + wv * 96;
    if (hi == 0) { const float* gl = (const float*)(P.ws + WS_GATES) + (size_t)(row0 + q) * 24 + wv * 3; gts[q] = sigm_fast(gl[0]); gts[32 + q] = sigm_fast(gl[1]); gts[64 + q] = sigm_fast(gl[2]); }
    unsigned lmask = (2u << bt) - 1u, gunion = lmask, uall = lmask;
    {
        const size_t cb = (size_t)b * 2 * 128 * 64;
        TileSrc S{(const h16*)(P.ws + WS_KCNH) + cb, (const h16*)(P.ws + WS_KCNH) + cb + 128 * 64, (const h16*)(P.ws + WS_VCC) + cb, (const h16*)(P.ws + WS_VCC) + cb + 128 * 64};
        const bool two = (q0 >> 4) >= 64;
        tile_dma(S, 0, lds, W, wv);
        if (two) tile_dma(S, 64, lds + STAGE_B, W, wv);
        __syncthreads();
        f32x16 O[2], pA, pB;
#pragma unroll
        for (int r = 0; r < 16; ++r) { O[0][r] = 0.f; O[1][r] = 0.f; pA[r] = 0.f; pB[r] = 0.f; }
        float mhat = ((FA_LAS const float*)(lds + L_CB))[wv], lsum = 0.f;
        const int nq = tq >= 31 ? (tq - 31) >> 4 : -1;
        tile_step<true, true, 16, 0>(lds + g * 8192, lds + 16384 + g * 8192, W, qf, O, mhat, lsum, -mhat, tq - 31, -1000, nq, pA, pB);
        if (two) tile_step<true, true, 16, 8>(lds + STAGE_B + g * 8192, lds + STAGE_B + 16384 + g * 8192, W, qf, O, mhat, lsum, -mhat, tq - 31 - 1024, -1000, nq - 64, pA, pB);
        const float lt = lsum + __shfl_xor(lsum, 32);
        const float inv = lt > 0.f ? 1.f / lt : 0.f;
        const float sc = gts[q] * inv;
#pragma unroll
        for (int r = 0; r < 16; ++r) { O[0][r] *= sc; O[1][r] *= sc; }
        if (bt >= 16) {
            FA_LAS float* slab = (FA_LAS float*)(lds + L_SLAB) + (wv * 32 + q) * 32;
#pragma unroll
            for (int i = 0; i < 16; ++i) {
                const float a = pA[i] * inv, bv = pB[i] * inv;
                const float rc = __shfl_xor(bv, 32);
                float rp = 0.f;
                if (i > 0) rp = __shfl_xor(pB[i - 1] * inv, 32);
                slab[2 * i + hi] = a + (hi ? rc : rp);
            }
        }
        __syncthreads();
        if (bt >= 16) {
            FA_LAS const float* slabs = (FA_LAS const float*)(lds + L_SLAB);
            FA_LAS unsigned* selm = (FA_LAS unsigned*)(lds + L_SELM);
            int lane2 = threadIdx.x & 63; asm volatile("" : "+v"(lane2));
            const int j = lane2 & 31;
#pragma unroll 1
            for (int it = 0; it < 4; ++it) {
                const int rr = 8 * wv + 2 * it + (lane2 >> 5), gg = rr >> 5, qq = rr & 31;
                float sc2 = 0.f;
#pragma unroll
                for (int hh = 0; hh < 4; ++hh) sc2 += slabs[((gg * 4 + hh) * 32 + qq) * 32 + j];
                FA_LAS float* srow = (FA_LAS float*)(lds + 139520) + wv * 64 + (lane2 & 32);
                srow[j] = sc2;
                int rank = 0;
#pragma unroll
                for (int i4 = 0; i4 < 8; ++i4) {
                    const fg::f32x4 s4 = *(FA_LAS const fg::f32x4*)(srow + 4 * i4);
                    const float sv[4] = {s4[0], s4[1], s4[2], s4[3]};
#pragma unroll
                    for (int e = 0; e < 4; ++e) { const int i = 4 * i4 + e; rank += (i >= 1 && i <= bt - 2 && (sv[e] > sc2 || (sv[e] == sc2 && i < j))) ? 1 : 0; }
                }
                const bool forced = (j == 0 || j == bt || j == bt - 1), cand = (j >= 1 && j <= bt - 2);
                const bool sel = forced || (cand && rank < 13);
                const unsigned long long m64 = __ballot(sel);
                if (lane2 == 0) { selm[8 * wv + 2 * it] = (unsigned)m64; selm[8 * wv + 2 * it + 1] = (unsigned)(m64 >> 32); }
            }
            __syncthreads();
            lmask = selm[g * 32 + (lane2 & 31)];
            gunion = wave_or(lmask);
            uall = wave_or(selm[lane2]);
            gunion = __builtin_amdgcn_readfirstlane(gunion); uall = __builtin_amdgcn_readfirstlane(uall);
        }
#pragma unroll
        for (int r = 0; r < 16; ++r) { OtL[r * 64] = O[0][r]; OtL[(16 + r) * 64] = O[1][r]; }
    }
    {
        const size_t kb = (size_t)b * 2 * 2048 * 64;
        TileSrc S{(const h16*)(P.ws + WS_KS) + kb, (const h16*)(P.ws + WS_KS) + kb + 2048 * 64, (const h16*)(P.ws + WS_VS) + kb, (const h16*)(P.ws + WS_VS) + kb + 2048 * 64};
        f32x16 O[2];
#pragma unroll
        for (int r = 0; r < 16; ++r) { O[0][r] = 0.f; O[1][r] = 0.f; }
        float mhat = ((FA_LAS const float*)(lds + L_CB))[8 + wv], lsum = 0.f;
        branch_loop<1>(uall, S, lds, W, qf, O, mhat, lsum, g, wv, tq, bt, 0, lmask, gunion);
        const float lt = lsum + __shfl_xor(lsum, 32);
        const float sc = gts[32 + q] / lt;
#pragma unroll
        for (int r = 0; r < 16; ++r) { OtL[r * 64] += sc * O[0][r]; OtL[(16 + r) * 64] += sc * O[1][r]; }
    }
    {
        const size_t kb = (size_t)b * 2 * 2048 * 64;
        TileSrc S{(const h16*)(P.ws + WS_KW) + kb, (const h16*)(P.ws + WS_KW) + kb + 2048 * 64, (const h16*)(P.ws + WS_VW) + kb, (const h16*)(P.ws + WS_VW) + kb + 2048 * 64};
        f32x16 O[2];
#pragma unroll
        for (int r = 0; r < 16; ++r) { O[0][r] = 0.f; O[1][r] = 0.f; }
        float mhat = ((FA_LAS const float*)(lds + L_CB))[16 + wv], lsum = 0.f;
        const int jlo = q0 >= 511 ? (q0 - 511) >> 6 : 0;
        const unsigned wmask = ((2u << bt) - 1u) & ~((1u << jlo) - 1u);
        branch_loop<2>(wmask, S, lds, W, qf, O, mhat, lsum, g, wv, tq, bt, q0 >= 511 ? jlo : -1, 0u, 0u);
        const float lt = lsum + __shfl_xor(lsum, 32);
        const float sc = gts[64 + q] / lt;
        float ss = 0.f;
#pragma unroll
        for (int r = 0; r < 16; ++r) { O[0][r] = OtL[r * 64] + sc * O[0][r]; O[1][r] = OtL[(16 + r) * 64] + sc * O[1][r]; ss += O[0][r] * O[0][r] + O[1][r] * O[1][r]; }
        ss += __shfl_xor(ss, 32);
        int tid2 = threadIdx.x; asm volatile("" : "+v"(tid2));
        const int q2 = tid2 & 31, hi2 = (tid2 >> 5) & 1;
        FA_LAS float* ssq = (FA_LAS float*)(lds + L_SSQ);
        if (hi2 == 0) ssq[wv * 32 + q2] = ss;
        __syncthreads();
        float tot = 0.f;
#pragma unroll
        for (int w = 0; w < 8; ++w) tot += ssq[w * 32 + q2];
        const float rstd = rsqrtf(tot * (1.f / 512.f) + EPSF);
#pragma unroll
        for (int db = 0; db < 2; ++db)
#pragma unroll
            for (int g4 = 0; g4 < 4; ++g4) {
                h16x4 o;
#pragma unroll
                for (int i = 0; i < 4; ++i) o[i] = (h16)(O[db][4 * g4 + i] * rstd);
                *(FA_LAS h16x4*)(lds + q2 * OST_PITCH + (wv * 64 + 32 * db + 8 * g4 + 4 * hi2) * 2) = o;
            }
        __syncthreads();
        h16* Y = (h16*)(P.ws + WS_Y);
#pragma unroll
        for (int i = 0; i < 4; ++i) {
            const int cid = tid2 + 512 * i, rw = cid >> 6, cc = cid & 63;
            const h16x8 v = *(FA_LAS const h16x8*)(lds + rw * OST_PITCH + cc * 16);
            *(h16x8*)(Y + (size_t)(row0 + rw) * 1024 + cc * 8) = v;
        }
        __syncthreads();
    }
}

DEVI void attn_phase(const Params& P, unsigned char* lds_raw) {
    FA_LAS unsigned char* lds = (FA_LAS unsigned char*)lds_raw;
    FA_LAS float* bias = (FA_LAS float*)(lds + L_BIAS);
    for (int i = threadIdx.x; i < 8 * 128; i += 512) { const int h = i >> 7, n = i & 127; bias[i] = P.rel_bias[t5_bucket(n) * 8 + h] * LOG2E; }
    if (threadIdx.x < 24) {
        const int br = threadIdx.x >> 3, h = threadIdx.x & 7;
        const float* kg = br == 0 ? P.k_cmp_gain : br == 1 ? P.k_sel_gain : P.k_win_gain;
        float gq = 0.f, gk = 0.f, tb = 0.f;
        for (int d = 0; d < 64; ++d) { gq = fmaxf(gq, fabsf(P.q_gain[d])); gk = fmaxf(gk, fabsf(kg[d])); }
        for (int n = 0; n < 32; ++n) tb = fmaxf(tb, fabsf(P.rel_bias[n * 8 + h]));
        ((FA_LAS float*)(lds + L_CB))[threadIdx.x] = LOG2E * (8.f * gq * gk + tb) + 0.5f;
    }
    __syncthreads();
    if (gridDim.x == 256) {
        const int x = blockIdx.x & 7, m = blockIdx.x >> 3;
#pragma unroll 1
        for (int i = 0; i < 4; ++i) attn_unit(P, lds, 2 * x + (i >> 1), (i & 1) ? m : 63 - m);
    } else {
#pragma unroll 1
        for (int u = blockIdx.x; u < 1024; u += gridDim.x) attn_unit(P, lds, u >> 6, u & 63);
    }
}
}

#define LAS __attribute__((address_space(3)))
#define XB_TMO      128
#define XB_XCNT(j)  (256  + 64 * (j))
#define XB_XSUB(j)  (1280 + 64 * (j))
#define XB_XGEN(j)  (2304 + 64 * (j))
#define XB_TOP      3328
#define XB_TOPGEN   3392
#define XCD_BAR_WORDS 3456
#define XB_SPIN_CAP (1u << 22)
__device__ __forceinline__ unsigned xb_ld(unsigned* p)              { return __hip_atomic_load(p, __ATOMIC_RELAXED, __HIP_MEMORY_SCOPE_AGENT); }
__device__ __forceinline__ unsigned xb_add(unsigned* p, unsigned v) { return __hip_atomic_fetch_add(p, v, __ATOMIC_RELAXED, __HIP_MEMORY_SCOPE_AGENT); }
__device__ __forceinline__ unsigned xb_xcc_id() { return (unsigned)__builtin_amdgcn_s_getreg((3 << 11) | 20) & 0xFu; }
#define XB_SPIN(cond, bar) do { unsigned _sp = 0; while (cond) { __builtin_amdgcn_s_sleep(1); \
    if ((++_sp & 255u) == 0u) { if (xb_ld(&(bar)[XB_TMO])) break; if (_sp > XB_SPIN_CAP) { atomicAdd(&(bar)[XB_TMO], 1u); break; } } } } while (0)
struct XcdBarrier { unsigned* bar; unsigned x; volatile LAS unsigned* st; };
__device__ __forceinline__ XcdBarrier xcd_barrier_post(unsigned* bar, volatile LAS unsigned* st) {
    XcdBarrier b; b.bar = bar; b.x = xb_xcc_id(); b.st = st;
    if (threadIdx.x == 0) (void)xb_add(&bar[XB_XCNT(b.x)], 1u);
    return b;
}
__device__ __forceinline__ void xcd_barrier_complete(unsigned* bar, unsigned x, unsigned& nloc, unsigned& nx) {
    const unsigned G = gridDim.x * gridDim.y * gridDim.z;
    unsigned sum, cnt, mine, sp = 0u;
    for (;;) {
        sum = 0u; cnt = 0u; mine = 0u;
#pragma unroll
        for (unsigned j = 0; j < 16; ++j) { const unsigned c = xb_ld(&bar[XB_XCNT(j)]); sum += c; cnt += (c > 0u) ? 1u : 0u; mine = (j == x) ? c : mine; }
        if (sum == G) break;
        __builtin_amdgcn_s_sleep(1);
        if ((++sp & 255u) == 0u) { if (xb_ld(&bar[XB_TMO])) break; if (sp > XB_SPIN_CAP) { atomicAdd(&bar[XB_TMO], 1u); break; } }
    }
    nloc = mine > 0u ? mine : 1u; nx = cnt > 0u ? cnt : 1u;
}
__device__ __forceinline__ void xcd_barrier(const XcdBarrier& b) {
    asm volatile("s_waitcnt vmcnt(0)" ::: "memory");
    __syncthreads();
    if (threadIdx.x == 0) {
        unsigned* bar = b.bar;
        __builtin_amdgcn_s_waitcnt(0);
        unsigned nloc = b.st[0], nx = b.st[1];
        if (nloc == 0u) { xcd_barrier_complete(bar, b.x, nloc, nx); b.st[0] = nloc; b.st[1] = nx; }
        const unsigned old = xb_add(&bar[XB_XSUB(b.x)], 1u);
        const unsigned gen = old / nloc;
        if (old + 1u == (gen + 1u) * nloc) {
            __builtin_amdgcn_fence(__ATOMIC_RELEASE, "agent");
            asm volatile("s_waitcnt vmcnt(0)" ::: "memory");
            const unsigned og = xb_add(&bar[XB_TOP], 1u);
            const unsigned tg = og / nx;
            if (og + 1u == (tg + 1u) * nx) xb_add(&bar[XB_TOPGEN], 1u);
            else XB_SPIN(xb_ld(&bar[XB_TOPGEN]) == tg, bar);
            __builtin_amdgcn_fence(__ATOMIC_ACQUIRE, "agent");
            xb_add(&bar[XB_XGEN(b.x)], 1u);
            asm volatile("s_waitcnt vmcnt(0)" ::: "memory");
        } else {
            XB_SPIN(xb_ld(&bar[XB_XGEN(b.x)]) == gen, bar);
            __builtin_amdgcn_fence(__ATOMIC_ACQUIRE, "agent");
            asm volatile("s_waitcnt vmcnt(0)" ::: "memory");
        }
    }
    __syncthreads();
}

constexpr int LDS_BYTES = 147456;
constexpr int MISC_OFF = 147456 - 256;
constexpr size_t CTL_ZERO_BYTES = 64 * 1024;
constexpr int CW_CMPF = 128;
constexpr int CW_BAR = 4096;
struct Args { Params P; int ph_lo, ph_hi, li, pad; };
__global__ void __launch_bounds__(512, 2) mega_fwd(Args a) {
    extern __shared__ __attribute__((aligned(16))) unsigned char lds_raw[];
    float* lds = (float*)lds_raw;
    const Params& P = a.P;
    volatile LAS unsigned* MISC = (volatile LAS unsigned*)((LAS unsigned char*)lds_raw + MISC_OFF);
    if (threadIdx.x < 32) MISC[threadIdx.x] = 0u;
    __syncthreads();
    XcdBarrier bar = xcd_barrier_post((unsigned*)(P.ws + WS_CTL) + CW_BAR + a.li * XCD_BAR_WORDS, MISC + 8);
    const int lo = a.ph_lo, hi = a.ph_hi;
#define IN(k) (lo <= (k) && (k) < hi)
#define SEAM(k) do { if (IN(k) && IN((k) + 1)) xcd_barrier(bar); } while (0)
#ifdef ONLY_ATTN
    fa::attn_phase(P, lds_raw); return;
#endif
    if (IN(0)) ph_prep2(P, lds);
    SEAM(0);
#ifdef PROBE_BARS
    for (int i = 0; i < PROBE_BARS; ++i) xcd_barrier(bar);
#endif
    if (IN(1)) ph_norm1_2(P, lds);
    SEAM(1);
    if (IN(2)) ph_inproj_fast(P, lds_raw);
    SEAM(2);
    if (IN(3)) {
        unsigned* cflag = (unsigned*)(P.ws + WS_CTL) + CW_CMPF + a.li * 64;
        ph_compress_fast(P, lds_raw);
        const unsigned ncmp = gridDim.x < 128u ? gridDim.x : 128u;
        if (blockIdx.x < ncmp && threadIdx.x == 0) { __builtin_amdgcn_fence(__ATOMIC_RELEASE, "agent"); asm volatile("s_waitcnt vmcnt(0)" ::: "memory"); xb_add(cflag, 1u); }
        ph_bias13_gemm(P, lds_raw);
        ph_conv2(P, lds);
        if (threadIdx.x == 0) { XB_SPIN(xb_ld(cflag) < ncmp, bar.bar); __builtin_amdgcn_fence(__ATOMIC_ACQUIRE, "agent"); asm volatile("s_waitcnt vmcnt(0)" ::: "memory"); }
        __syncthreads();
        ph_compress2b(P, lds);
    }
    SEAM(3);
    if (IN(4)) fa::attn_phase(P, lds_raw);
    SEAM(4);
    if (IN(5)) ph_outproj_fast(P, lds_raw);
    SEAM(5);
    if (IN(6)) ph_ffn1_fast(P, lds_raw);
    SEAM(6);
    if (IN(7)) ph_ffn2_fast(P, lds_raw);
#undef IN
#undef SEAM
}

#ifndef N_LAUNCHES
#define N_LAUNCHES 1
#endif
extern "C" void kernel_launch(void* const* d_in, const int* in_sizes, int n_in, void* d_out, int out_size, void* d_ws, size_t ws_size, hipStream_t stream) {
    static int grid = 0;
    if (grid == 0) {
        if (n_in != 25 || out_size != MTOK * DM || ws_size < WS_END) { fprintf(stderr, "kernel_launch: unexpected shapes n_in %d out %d ws %zu\n", n_in, out_size, ws_size); grid = -1; return; }
        int dev = 0, cus = 0, per_cu = 0;
        if (hipGetDevice(&dev) != hipSuccess || hipDeviceGetAttribute(&cus, hipDeviceAttributeMultiprocessorCount, dev) != hipSuccess) { grid = -1; return; }
        if (hipFuncSetAttribute((const void*)mega_fwd, hipFuncAttributeMaxDynamicSharedMemorySize, LDS_BYTES) != hipSuccess) { fprintf(stderr, "kernel_launch: hipFuncSetAttribute failed\n"); grid = -1; return; }
        if (hipOccupancyMaxActiveBlocksPerMultiprocessor(&per_cu, (const void*)mega_fwd, 512, LDS_BYTES) != hipSuccess || per_cu < 1) { fprintf(stderr, "kernel_launch: occupancy query says %d\n", per_cu); per_cu = 1; }
        (void)hipGetLastError();
        grid = cus;
    }
    if (grid < 0) return;
    (void)hipMemsetAsync((char*)d_ws + WS_CTL, 0, CTL_ZERO_BYTES, stream);
    Args a{};
    const float** pp = (const float**)&a.P;
    for (int i = 0; i < 25; ++i) pp[i] = (const float*)d_in[i];
    a.P.out = (float*)d_out;
    a.P.ws = (unsigned char*)d_ws;
#ifdef PROBE_TWICE
    { a.li = 0; a.ph_lo = 0; a.ph_hi = 8; hipLaunchKernelGGL(mega_fwd, dim3(grid), dim3(512), LDS_BYTES, stream, a);
      (void)hipMemsetAsync((char*)d_ws + WS_CTL, 0, 4096, stream);
      a.li = 1; hipLaunchKernelGGL(mega_fwd, dim3(grid), dim3(512), LDS_BYTES, stream, a); return; }
#endif
#ifdef PROBE_PH
    { const int k = PROBE_PH;
      a.ph_lo = 0; a.ph_hi = k + 1; hipLaunchKernelGGL(mega_fwd, dim3(grid), dim3(512), LDS_BYTES, stream, a);
      a.li = 1; a.ph_lo = k; a.ph_hi = k + 1; hipLaunchKernelGGL(mega_fwd, dim3(grid), dim3(512), LDS_BYTES, stream, a);
      a.li = 2; a.ph_lo = k + 1; a.ph_hi = 8; if (k + 1 < 8) hipLaunchKernelGGL(mega_fwd, dim3(grid), dim3(512), LDS_BYTES, stream, a); return; }
#endif
    if (N_LAUNCHES == 1) { a.ph_lo = 0; a.ph_hi = 8; hipLaunchKernelGGL(mega_fwd, dim3(grid), dim3(512), LDS_BYTES, stream, a); }
    else for (int ph = 0; ph < 8; ++ph) { a.ph_lo = ph; a.ph_hi = ph + 1; hipLaunchKernelGGL(mega_fwd, dim3(grid), dim3(512), LDS_BYTES, stream, a); }
}
```

```cpp
#include <hip/hip_runtime.h>
#include <cstdio>
#include <cstdint>

constexpr int DM = 1024, NB = 16, SEQ = 2048, MTOK = NB * SEQ, HD = 64, NH = 8;
constexpr int NPROJ = 2840, DFF = 2816, NCMP = 127;
constexpr float EPSF = 1e-6f;

typedef _Float16 h16;
typedef _Float16 h16x4 __attribute__((ext_vector_type(4)));
typedef _Float16 h16x8 __attribute__((ext_vector_type(8)));
typedef __bf16 bf16x8_t __attribute__((ext_vector_type(8)));

constexpr size_t MiB = 1u << 20;
constexpr size_t WS_CTL = 0;
constexpr size_t WS_MOD = 1 * MiB;
constexpr size_t WS_BIAS13 = 1 * MiB + 512 * 1024;
constexpr size_t WS_SSQ2 = 2 * MiB;
constexpr size_t WS_KCNH = 4 * MiB;
constexpr size_t WS_KCNL = 4 * MiB + 512 * 1024;
constexpr size_t WS_VCC = 5 * MiB;
constexpr size_t WS_GATES = 6 * MiB;
constexpr size_t WS_A1H = 40 * MiB, WS_A1L = 104 * MiB;
constexpr size_t WS_QH = 168 * MiB, WS_QL = 200 * MiB;
constexpr size_t WS_KCH = 232 * MiB, WS_KCL = 240 * MiB, WS_VC = 248 * MiB, WS_KS = 256 * MiB, WS_VS = 264 * MiB, WS_KW = 272 * MiB, WS_VW = 280 * MiB;
constexpr size_t WS_BCX = 292 * MiB;
constexpr size_t WS_Y = 40 * MiB;
constexpr size_t WS_A2 = 232 * MiB;
constexpr size_t WS_U = 296 * MiB;
constexpr size_t WS_X1H = 168 * MiB;
constexpr size_t WS_END = 472 * MiB;

struct Params {
    const float *x, *c, *w_ada, *b_ada, *norm1_gain, *w_in, *q_gain, *k_cmp_gain, *k_sel_gain, *k_win_gain, *cmp_pos_k, *cmp_pos_v,
        *w_ck1, *w_ck2, *w_cv1, *w_cv2, *rel_bias, *conv_w, *attn_out_gain, *conv_out_gain, *w_out, *norm2_gain, *w_ff1, *w_ff3, *w_ff2;
    float* out;
    unsigned char* ws;
};

#define DEVI __device__ __forceinline__

DEVI float wsum(float v) {
#pragma unroll
    for (int o = 32; o > 0; o >>= 1) v += __shfl_xor(v, o);
    return v;
}
DEVI float wmax(float v) {
#pragma unroll
    for (int o = 32; o > 0; o >>= 1) v = fmaxf(v, __shfl_xor(v, o));
    return v;
}
DEVI float siluf(float v) { return v / (1.f + expf(-v)); }
DEVI float sigmf(float v) { return 1.f / (1.f + expf(-v)); }
DEVI float sigm_fast(float v) { return __builtin_amdgcn_rcpf(1.f + __builtin_amdgcn_exp2f(-1.4426950408889634f * v)); }
DEVI float silu_fast(float v) { return v * sigm_fast(v); }
DEVI int t5_bucket(int n) {
    if (n < 16) return n;
    int large = 16 + (int)(logf((float)n / 16.f) / 2.0794415416798357f * 16.f);
    return large < 31 ? large : 31;
}

namespace fg {
#define FG_LAS __attribute__((address_space(3)))
typedef float f32x4 __attribute__((ext_vector_type(4)));
typedef unsigned u32x4 __attribute__((ext_vector_type(4)));
typedef unsigned u32x2 __attribute__((ext_vector_type(2)));
constexpr int BM = 256, BK = 64, HALF = 128, HTB = HALF * BK * 2, STAGE_BYTES = 8 * HTB, NXCD = 8, WGM = 8;
__host__ __device__ __forceinline__ int lds_byte(int r, int c) { const int st = (r >> 4) * 2 + (c >> 5), rr = r & 15, cc = c & 31, ob = rr * 64 + cc * 2; return st * 1024 + (ob ^ (((ob >> 9) & 1) << 5)); }
__host__ __device__ __forceinline__ void stage_rc(int b, int& R, int& C) { const int st = b / 1024, sb = b % 1024, swz = sb ^ (((sb >> 9) & 1) << 5); R = (st >> 1) * 16 + swz / 64; C = (st & 1) * 32 + (swz % 64) / 2; }
__host__ __device__ __forceinline__ int perm32(int rho) { const int n = rho >> 4, i = rho & 15; return 8 * (i >> 2) + 4 * n + (i & 3); }
struct Unit { int pm, pn; };
struct Gemm {
    const h16* A; const h16* A2; const h16* Bt; int M, N, K, lda; size_t hstepA; int ldb;
    DEVI const char* a_tile(const Unit& u) const { return A2 ? (const char*)((u.pn & 1) ? A2 : A) + (size_t)u.pm * 2 * hstepA + (size_t)(u.pn >> 1) * K * 2 : (const char*)A + (size_t)u.pm * 2 * hstepA; }
    DEVI const char* b_tile(const Unit& u) const { return A2 ? (const char*)Bt + (size_t)(u.pn & 1) * 2 * HALF * ldb * 2 + (size_t)(u.pn >> 1) * K * 2 : (const char*)Bt + (size_t)u.pn * 2 * HALF * ldb * 2; }
};
struct StaticOrder {
    int nM, nN, nwg, G, c;
    __host__ __device__ void init(int M, int N, int G_, int c_) { nM = M / BM; nN = N / BM; nwg = nM * nN; G = G_; c = c_; }
    __host__ __device__ bool next(int i, Unit& u) const {
        const long L = (long)i * G + c; if (L >= nwg) return false;
        int wgid = (int)L; { const int q = nwg / NXCD, r = nwg % NXCD, xcd = wgid % NXCD, off = wgid / NXCD; wgid = (xcd < r ? xcd * (q + 1) : r * (q + 1) + (xcd - r) * q) + off; }
        const int nig = WGM * nN, gid = wgid / nig, fm = gid * WGM, gsz = (nM - fm) < WGM ? (nM - fm) : WGM;
        u.pm = fm + ((wgid % nig) % gsz); u.pn = (wgid % nig) / gsz; return true;
    }
};
#ifndef FG_ALIGN
#define FG_ALIGN true
#endif
#ifndef FG_SP2
#define FG_SP2 true
#endif
template <class Epi, bool ALIGN_EPI = FG_ALIGN, bool SP2 = FG_SP2>
DEVI void gemm_phase(FG_LAS unsigned char* lds, const Gemm g, const StaticOrder& S, const Epi& E) {
    const int tid = threadIdx.x, wid = __builtin_amdgcn_readfirstlane(tid >> 6), lane = tid & 63, wr = wid >> 2, wc = wid & 3, fr = lane & 15, fq = lane >> 4;
    const int K = g.K, nt = K / BK;
    unsigned voffA[2], voffB[2];
#pragma unroll
    for (int i = 0; i < 2; ++i) { int R, C; stage_rc(tid * 16 + i * 8192, R, C); const int Rb = Epi::PERM ? ((R & ~31) + perm32(R & 31)) : R;
        voffA[i] = (unsigned)(R * g.lda + C) * 2u; voffB[i] = (unsigned)(Rb * g.ldb + C) * 2u; }
    const size_t kstep = (size_t)(BK * 2);
    const size_t hstepA = g.hstepA, hstepB = (size_t)HALF * g.ldb * 2;
    const unsigned ldsw = (unsigned)wid * 1024u;
    const int aoff = lds_byte(wr * 64 + fr, fq * 8), boff = lds_byte(wc * 32 + fr, fq * 8);
#define FG_SA(b, h) (((b) * 2 + (h)) * HTB)
#define FG_SB(b, h) ((4 + (b) * 2 + (h)) * HTB)
#define FG_STAGE(bufoff, gbase, voff) do { _Pragma("unroll") for (int _i = 0; _i < 2; ++_i) \
        __builtin_amdgcn_global_load_lds((const unsigned*)((const char*)(gbase) + (voff)[_i]), (FG_LAS unsigned*)(lds + (bufoff) + ldsw + _i * 8192), 16, 0, 0); } while (0)
#define FG_LDA(dst, b, h) do { _Pragma("unroll") for (int m = 0; m < 4; ++m) _Pragma("unroll") for (int k = 0; k < 2; ++k) dst[m][k] = *(const FG_LAS h16x8*)(lds + FG_SA(b, h) + aoff + m * 2048 + k * 1024); } while (0)
#define FG_LDB(dst, b, h) do { _Pragma("unroll") for (int n = 0; n < 2; ++n) _Pragma("unroll") for (int k = 0; k < 2; ++k) dst[n][k] = *(const FG_LAS h16x8*)(lds + FG_SB(b, h) + boff + n * 2048 + k * 1024); } while (0)
#define FG_MMA(ai, bj, At, Bt) do { __builtin_amdgcn_s_setprio(1); _Pragma("unroll") for (int m = 0; m < 4; ++m) _Pragma("unroll") for (int n = 0; n < 2; ++n) _Pragma("unroll") for (int k = 0; k < 2; ++k) \
        acc[ai][bj][m][n] = __builtin_amdgcn_mfma_f32_16x16x32_f16(Bt[n][k], At[m][k], acc[ai][bj][m][n], 0, 0, 0); __builtin_amdgcn_s_setprio(0); } while (0)
#define FG_WAIT_V(n) asm volatile("s_waitcnt vmcnt(" #n ")" ::: "memory")
#define FG_WAIT_L(n) asm volatile("s_waitcnt lgkmcnt(" #n ")" ::: "memory")
#define FG_BAR __builtin_amdgcn_s_barrier()
#define FG_SCHED __builtin_amdgcn_sched_barrier(0)
    Unit cur, nxt; int ui = 0;
    if (!S.next(0, cur)) return;
    f32x4 acc[2][2][4][2];
#pragma unroll
    for (int a = 0; a < 2; ++a)
#pragma unroll
        for (int b = 0; b < 2; ++b)
#pragma unroll
            for (int m = 0; m < 4; ++m)
#pragma unroll
                for (int n = 0; n < 2; ++n) acc[a][b][m][n] = (f32x4){0.f, 0.f, 0.f, 0.f};
    h16x8 At[4][2], B0[2][2], B1[2][2];
    const char* cA = g.a_tile(cur); const char* cB = g.b_tile(cur);
    if constexpr (SP2) {
        FG_STAGE(FG_SB(0, 0), cB, voffB); FG_STAGE(FG_SB(0, 1), cB + hstepB, voffB); FG_STAGE(FG_SA(0, 0), cA, voffA); FG_STAGE(FG_SA(0, 1), cA + hstepA, voffA);
        if (wr == 1) FG_BAR;
        FG_WAIT_V(2); FG_BAR;
        FG_STAGE(FG_SB(1, 0), cB + kstep, voffB); FG_STAGE(FG_SA(1, 0), cA + kstep, voffA); FG_STAGE(FG_SB(1, 1), cB + hstepB + kstep, voffB);
        FG_WAIT_V(6); FG_BAR;
    } else {
        FG_STAGE(FG_SB(0, 0), cB, voffB); FG_STAGE(FG_SA(0, 0), cA, voffA); FG_STAGE(FG_SB(0, 1), cB + hstepB, voffB); FG_STAGE(FG_SA(0, 1), cA + hstepA, voffA);
        if (wr == 1) FG_BAR;
        FG_WAIT_V(4); FG_BAR;
        FG_STAGE(FG_SB(1, 0), cB + kstep, voffB); FG_STAGE(FG_SA(1, 0), cA + kstep, voffA); FG_STAGE(FG_SB(1, 1), cB + hstepB + kstep, voffB);
        FG_WAIT_V(6); FG_BAR;
    }
    for (;;) {
        const bool has_next = S.next(ui + 1, nxt);
        const char* nA = has_next ? g.a_tile(nxt) : cA; const char* nB = has_next ? g.b_tile(nxt) : cB;
        for (int t = 0; t < nt; t += 2) {
            const bool last = (t == nt - 2);
            const char* a1 = cA + (size_t)(t + 1) * kstep;
            const char* a2 = last ? nA : cA + (size_t)(t + 2) * kstep; const char* b2 = last ? nB : cB + (size_t)(t + 2) * kstep;
            const char* a3 = a2 + kstep; const char* b3 = b2 + kstep;
            if constexpr (SP2) {
            FG_LDB(B0, 0, 0); FG_LDB(B1, 0, 1); FG_SCHED; FG_LDA(At, 0, 0); FG_STAGE(FG_SA(1, 1), a1 + hstepA, voffA);
            FG_WAIT_V(8); FG_WAIT_L(0); FG_BAR; FG_MMA(0, 0, At, B0); FG_MMA(0, 1, At, B1); FG_BAR; FG_SCHED;
            FG_LDA(At, 0, 1); FG_STAGE(FG_SB(0, 0), b2, voffB); FG_STAGE(FG_SB(0, 1), b2 + hstepB, voffB); FG_STAGE(FG_SA(0, 0), a2, voffA);
            FG_WAIT_V(8); FG_WAIT_L(0); FG_BAR; FG_MMA(1, 0, At, B0); FG_MMA(1, 1, At, B1); FG_BAR; FG_SCHED;
            FG_LDB(B0, 1, 0); FG_LDB(B1, 1, 1); FG_SCHED; FG_LDA(At, 1, 0); FG_STAGE(FG_SA(0, 1), a2 + hstepA, voffA);
            FG_WAIT_V(8); FG_WAIT_L(0); FG_BAR; FG_MMA(0, 0, At, B0); FG_MMA(0, 1, At, B1); FG_BAR; FG_SCHED;
            FG_LDA(At, 1, 1); FG_STAGE(FG_SB(1, 0), b3, voffB); FG_STAGE(FG_SB(1, 1), b3 + hstepB, voffB); FG_STAGE(FG_SA(1, 0), a3, voffA);
            FG_WAIT_V(8); FG_WAIT_L(0); FG_BAR; FG_MMA(1, 0, At, B0); FG_MMA(1, 1, At, B1); FG_BAR; FG_SCHED;
            } else {
            FG_LDB(B0, 0, 0); FG_SCHED; FG_LDA(At, 0, 0); FG_STAGE(FG_SA(1, 1), a1 + hstepA, voffA);
            FG_WAIT_L(8); FG_BAR; FG_WAIT_L(0); FG_MMA(0, 0, At, B0); FG_BAR; FG_SCHED;
            FG_LDB(B1, 0, 1); FG_STAGE(FG_SB(0, 0), b2, voffB);
            FG_BAR; FG_WAIT_L(0); FG_MMA(0, 1, At, B1); FG_BAR;
            FG_LDA(At, 0, 1); FG_STAGE(FG_SA(0, 0), a2, voffA);
            FG_BAR; FG_WAIT_L(0); FG_MMA(1, 0, At, B0); FG_BAR; FG_SCHED;
            FG_STAGE(FG_SB(0, 1), b2 + hstepB, voffB);
            FG_WAIT_V(6); FG_BAR; FG_MMA(1, 1, At, B1); FG_BAR;
            FG_LDB(B0, 1, 0); FG_SCHED; FG_LDA(At, 1, 0); FG_STAGE(FG_SA(0, 1), a2 + hstepA, voffA);
            FG_WAIT_L(8); FG_BAR; FG_WAIT_L(0); FG_MMA(0, 0, At, B0); FG_BAR; FG_SCHED;
            FG_LDB(B1, 1, 1); FG_STAGE(FG_SB(1, 0), b3, voffB);
            FG_BAR; FG_WAIT_L(0); FG_MMA(0, 1, At, B1); FG_BAR;
            FG_LDA(At, 1, 1); FG_STAGE(FG_SA(1, 0), a3, voffA);
            FG_BAR; FG_WAIT_L(0); FG_MMA(1, 0, At, B0); FG_BAR; FG_SCHED;
            FG_STAGE(FG_SB(1, 1), b3 + hstepB, voffB);
            FG_WAIT_V(6); FG_BAR; FG_MMA(1, 1, At, B1); FG_BAR;
            }
        }
        if constexpr (ALIGN_EPI) { if (wr == 0) FG_BAR; }
        E(acc, cur, wr, wc, fr, fq);
        if (!has_next) break;
#pragma unroll
        for (int a = 0; a < 2; ++a)
#pragma unroll
            for (int b = 0; b < 2; ++b)
#pragma unroll
                for (int m = 0; m < 4; ++m)
#pragma unroll
                    for (int n = 0; n < 2; ++n) acc[a][b][m][n] = (f32x4){0.f, 0.f, 0.f, 0.f};
        cur = nxt; cA = nA; cB = nB; ++ui;
        if constexpr (ALIGN_EPI) { if (wr == 1) FG_BAR; }
    }
    FG_WAIT_V(0);
    if constexpr (!ALIGN_EPI) { if (wr == 0) FG_BAR; }
    FG_BAR;
#undef FG_SA
#undef FG_SB
#undef FG_STAGE
#undef FG_LDA
#undef FG_LDB
#undef FG_MMA
#undef FG_WAIT_V
#undef FG_WAIT_L
#undef FG_BAR
#undef FG_SCHED
}
}

constexpr size_t WS_WIN = 10 * MiB;
constexpr size_t WS_WOUT = 16 * MiB;
constexpr size_t WS_W13 = 18 * MiB;
constexpr size_t WS_W2 = 29 * MiB;
constexpr size_t WS_WC1 = 35 * MiB;
constexpr size_t WS_POSB = 9 * MiB;
constexpr size_t WS_HID = 104 * MiB;

DEVI int inproj_src(int nrow) {
    const int pn = nrow >> 8, tc = nrow & 255;
    if (pn < 5) { const int gi = 4 * pn + ((tc & 127) >> 5), d = 32 * (tc >> 7) + (tc & 31); return 64 * gi + d; }
    if (pn < 11) return 1304 + 256 * (pn - 5) + tc;
    return tc < 24 ? 1280 + tc : -1;
}
template <class SRC>
DEVI void transpose_item(const SRC& src, int K, h16* WT, float* scr, int item, int nblk, int lane) {
    const int kb = item / nblk, nb = item % nblk, k0 = 64 * kb, n0 = 32 * nb;
    float tv[32];
#pragma unroll
    for (int i = 0; i < 32; ++i) tv[i] = src(k0 + 2 * i + (lane >> 5), n0 + (lane & 31));
#pragma unroll
    for (int i = 0; i < 32; ++i) scr[(2 * i + (lane >> 5)) * 33 + (lane & 31)] = tv[i];
    asm volatile("s_waitcnt lgkmcnt(0)" ::: "memory");
    const int c = lane & 7;
#pragma unroll
    for (int j = 0; j < 4; ++j) { const int n = (lane >> 3) + 8 * j; const float* s = scr + (8 * c) * 33 + n;
        h16x8 o;
#pragma unroll
        for (int q = 0; q < 8; ++q) o[q] = (h16)s[q * 33];
        *(h16x8*)(WT + (size_t)(n0 + n) * K + k0 + 8 * c) = o; }
    asm volatile("s_waitcnt lgkmcnt(0)" ::: "memory");
}
struct SrcWin { const float* W; DEVI float operator()(int k, int n) const { const int s = inproj_src(n); return s < 0 ? 0.f : W[(size_t)k * NPROJ + s]; } };
struct SrcWout { const float *W, *ga, *gc; DEVI float operator()(int k, int n) const { return W[(size_t)k * 1024 + n] * (k < 512 ? ga[k] : gc[k - 512]); } };
struct SrcW13 { const float *W1, *W3; DEVI float operator()(int k, int n) const { const int pn = n >> 8, tc = n & 255; return tc < 128 ? W1[(size_t)k * DFF + 128 * pn + tc] : W3[(size_t)k * DFF + 128 * pn + tc - 128]; } };
struct SrcW2 { const float* W; DEVI float operator()(int k, int n) const { return W[(size_t)k * 1024 + n]; } };
struct SrcWc1 { const float *Wk, *Wv; DEVI float operator()(int k, int n) const { return n < 256 ? Wk[(size_t)k * 256 + n] : Wv[(size_t)k * 256 + n - 256]; } };
struct EF_ffn2 {
    static constexpr bool PERM = true;
    const Params* P;
    DEVI void operator()(const fg::f32x4 (&acc)[2][2][4][2], const fg::Unit& u, int wr, int wc, int fr, int fq) const {
        const Params& p = *P;
        const float* mod = (const float*)(p.ws + WS_MOD);
        const h16* X1 = (const h16*)(p.ws + WS_X1H);
        const int b = (u.pm * 256) >> 11;
#pragma unroll
        for (int bj = 0; bj < 2; ++bj) {
            const int col = u.pn * 256 + 128 * bj + 32 * wc + 8 * fq;
            h16x8 xv[2][4];
#pragma unroll
            for (int ai = 0; ai < 2; ++ai)
#pragma unroll
                for (int m = 0; m < 4; ++m) xv[ai][m] = *(const h16x8*)(X1 + (size_t)(u.pm * 256 + 128 * ai + 64 * wr + 16 * m + fr) * 1024 + col);
            fg::f32x4 g2[2];
#pragma unroll
            for (int n = 0; n < 2; ++n) g2[n] = *(const fg::f32x4*)(mod + b * 6144 + 5120 + col + 4 * n);
#pragma unroll
            for (int ai = 0; ai < 2; ++ai)
#pragma unroll
                for (int m = 0; m < 4; ++m) {
                    float* op = p.out + (size_t)(u.pm * 256 + 128 * ai + 64 * wr + 16 * m + fr) * 1024 + col;
#pragma unroll
                    for (int n = 0; n < 2; ++n) {
                        fg::f32x4 o;
#pragma unroll
                        for (int i = 0; i < 4; ++i) o[i] = (float)xv[ai][m][4 * n + i] + g2[n][i] * acc[ai][bj][m][n][i];
                        *(fg::f32x4*)(op + 4 * n) = o;
                    }
                }
        }
    }
};
DEVI void ph_ffn2_fast(const Params& P, unsigned char* lds_raw) {
    fg::Gemm g{(const h16*)(P.ws + WS_U), nullptr, (const h16*)(P.ws + WS_W2), MTOK, 1024, DFF, DFF, (size_t)128 * DFF * 2, DFF};
    fg::StaticOrder S; S.init(MTOK, 1024, gridDim.x, blockIdx.x);
    EF_ffn2 E{&P};
    fg::gemm_phase<EF_ffn2>((FG_LAS unsigned char*)lds_raw, g, S, E);
}

struct EF_ffn1 {
    static constexpr bool PERM = true;
    const Params* P;
    DEVI void operator()(const fg::f32x4 (&acc)[2][2][4][2], const fg::Unit& u, int wr, int wc, int fr, int fq) const {
        const Params& p = *P;
        const float* bias13 = (const float*)(p.ws + WS_BIAS13);
        const float* SSQ = (const float*)(p.ws + WS_SSQ2);
        h16* U = (h16*)(p.ws + WS_U);
        const int b = (u.pm * 256) >> 11, col = 128 * u.pn + 32 * wc + 8 * fq;
        fg::f32x4 sq[2][4];
#pragma unroll
        for (int ai = 0; ai < 2; ++ai)
#pragma unroll
            for (int m = 0; m < 4; ++m) sq[ai][m] = *(const fg::f32x4*)(SSQ + (size_t)(u.pm * 256 + 128 * ai + 64 * wr + 16 * m + fr) * 16 + 4 * fq);
        fg::f32x4 b1[2], b3[2];
#pragma unroll
        for (int n = 0; n < 2; ++n) { b1[n] = *(const fg::f32x4*)(bias13 + b * 5632 + col + 4 * n); b3[n] = *(const fg::f32x4*)(bias13 + b * 5632 + 2816 + col + 4 * n); }
        float rstd[2][4];
#pragma unroll
        for (int ai = 0; ai < 2; ++ai)
#pragma unroll
            for (int m = 0; m < 4; ++m) {
                float s = (sq[ai][m][0] + sq[ai][m][1]) + (sq[ai][m][2] + sq[ai][m][3]);
                s += __shfl_xor(s, 16); s += __shfl_xor(s, 32);
                rstd[ai][m] = rsqrtf(s * (1.f / 1024.f) + EPSF);
            }
#pragma unroll
        for (int ai = 0; ai < 2; ++ai)
#pragma unroll
            for (int m = 0; m < 4; ++m) {
                const int row = u.pm * 256 + 128 * ai + 64 * wr + 16 * m + fr;
                h16x8 o;
#pragma unroll
                for (int n = 0; n < 2; ++n)
#pragma unroll
                    for (int i = 0; i < 4; ++i) {
                        const float a = rstd[ai][m] * acc[ai][0][m][n][i] + b1[n][i];
                        const float c = rstd[ai][m] * acc[ai][1][m][n][i] + b3[n][i];
                        o[4 * n + i] = (h16)(silu_fast(a) * c);
                    }
                *(h16x8*)(U + (size_t)row * DFF + col) = o;
            }
    }
};
DEVI void ph_ffn1_fast(const Params& P, unsigned char* lds_raw) {
    fg::Gemm g{(const h16*)(P.ws + WS_A2), nullptr, (const h16*)(P.ws + WS_W13), MTOK, 5632, 1024, 1024, (size_t)128 * 1024 * 2, 1024};
    fg::StaticOrder S; S.init(MTOK, 5632, gridDim.x, blockIdx.x);
    EF_ffn1 E{&P};
    fg::gemm_phase<EF_ffn1>((FG_LAS unsigned char*)lds_raw, g, S, E);
}

struct EF_outproj {
    static constexpr bool PERM = true;
    const Params* P;
    DEVI void operator()(const fg::f32x4 (&acc)[2][2][4][2], const fg::Unit& u, int wr, int wc, int fr, int fq) const {
        const Params& p = *P;
        const float* mod = (const float*)(p.ws + WS_MOD);
        h16* A2 = (h16*)(p.ws + WS_A2);
        h16* X1 = (h16*)(p.ws + WS_X1H);
        float* SSQ = (float*)(p.ws + WS_SSQ2);
        const int b = (u.pm * 256) >> 11;
        float ss[2][4];
#pragma unroll
        for (int ai = 0; ai < 2; ++ai)
#pragma unroll
            for (int m = 0; m < 4; ++m) ss[ai][m] = 0.f;
#pragma unroll
        for (int bj = 0; bj < 2; ++bj) {
            const int col = u.pn * 256 + 128 * bj + 32 * wc + 8 * fq;
            fg::f32x4 g1[2], gs[2];
#pragma unroll
            for (int n = 0; n < 2; ++n) {
                g1[n] = *(const fg::f32x4*)(mod + b * 6144 + 2048 + col + 4 * n);
                const fg::f32x4 s2 = *(const fg::f32x4*)(mod + b * 6144 + 4096 + col + 4 * n), n2 = *(const fg::f32x4*)(p.norm2_gain + col + 4 * n);
                gs[n] = n2 * (s2 + 1.f);
            }
#pragma unroll
            for (int ai = 0; ai < 2; ++ai) {
                fg::f32x4 xv[4][2];
#pragma unroll
                for (int m = 0; m < 4; ++m) { const float* xp = p.x + (size_t)(u.pm * 256 + 128 * ai + 64 * wr + 16 * m + fr) * 1024 + col; xv[m][0] = *(const fg::f32x4*)xp; xv[m][1] = *(const fg::f32x4*)(xp + 4); }
#pragma unroll
                for (int m = 0; m < 4; ++m) {
                    const int row = u.pm * 256 + 128 * ai + 64 * wr + 16 * m + fr;
                    h16x8 xh, ah;
#pragma unroll
                    for (int n = 0; n < 2; ++n) {
                        const fg::f32x4 x1 = xv[m][n] + g1[n] * acc[ai][bj][m][n];
                        const fg::f32x4 a = x1 * gs[n];
#pragma unroll
                        for (int i = 0; i < 4; ++i) { xh[4 * n + i] = (h16)x1[i]; ah[4 * n + i] = (h16)a[i]; }
                        ss[ai][m] += (x1[0] * x1[0] + x1[1] * x1[1]) + (x1[2] * x1[2] + x1[3] * x1[3]);
                    }
                    *(h16x8*)(X1 + (size_t)row * 1024 + col) = xh;
                    *(h16x8*)(A2 + (size_t)row * 1024 + col) = ah;
                }
            }
        }
#pragma unroll
        for (int ai = 0; ai < 2; ++ai)
#pragma unroll
            for (int m = 0; m < 4; ++m) {
                float s = ss[ai][m];
                s += __shfl_xor(s, 16); s += __shfl_xor(s, 32);
                if (fq == 0) SSQ[(size_t)(u.pm * 256 + 128 * ai + 64 * wr + 16 * m + fr) * 16 + u.pn * 4 + wc] = s;
            }
    }
};
DEVI void ph_outproj_fast(const Params& P, unsigned char* lds_raw) {
    fg::Gemm g{(const h16*)(P.ws + WS_Y), nullptr, (const h16*)(P.ws + WS_WOUT), MTOK, 1024, 1024, 1024, (size_t)128 * 1024 * 2, 1024};
    fg::StaticOrder S; S.init(MTOK, 1024, gridDim.x, blockIdx.x);
    EF_outproj E{&P};
    fg::gemm_phase<EF_outproj>((FG_LAS unsigned char*)lds_raw, g, S, E);
}

struct EF_inproj {
    static constexpr bool PERM = true;
    const Params* P;
    DEVI void operator()(const fg::f32x4 (&acc)[2][2][4][2], const fg::Unit& u, int wr, int wc, int fr, int fq) const {
        const Params& p = *P;
        const int pn = u.pn;
        if (pn < 5) {
            const int gi = 4 * pn + wc;
            const int kind = gi < 8 ? 0 : 1 + ((gi - 8) >> 1), g = gi & 1;
            const bool normed = (kind == 0 || kind == 3 || kind == 5);
            const float qsc = kind == 0 ? 0.125f * 1.4426950408889634f : 1.f;
            const float* gn = kind == 0 ? p.q_gain : kind == 3 ? p.k_sel_gain : p.k_win_gain;
            fg::f32x4 gv[2][2];
#pragma unroll
            for (int bj = 0; bj < 2; ++bj)
#pragma unroll
                for (int n = 0; n < 2; ++n) gv[bj][n] = normed ? *(const fg::f32x4*)(gn + 32 * bj + 8 * fq + 4 * n) : (fg::f32x4){1.f, 1.f, 1.f, 1.f};
            h16* base = (h16*)(p.ws + (kind == 0 ? WS_QH : kind == 1 ? WS_KCH : kind == 2 ? WS_VC : kind == 3 ? WS_KS : kind == 4 ? WS_VS : kind == 5 ? WS_KW : WS_VW));
#pragma unroll
            for (int ai = 0; ai < 2; ++ai)
#pragma unroll
                for (int m = 0; m < 4; ++m) {
                    const int row = u.pm * 256 + 128 * ai + 64 * wr + 16 * m + fr;
                    float ss = 0.f;
#pragma unroll
                    for (int bj = 0; bj < 2; ++bj)
#pragma unroll
                        for (int n = 0; n < 2; ++n) { const fg::f32x4 v = acc[ai][bj][m][n]; ss += (v[0] * v[0] + v[1] * v[1]) + (v[2] * v[2] + v[3] * v[3]); }
                    ss += __shfl_xor(ss, 16); ss += __shfl_xor(ss, 32);
                    const float rstd = normed ? rsqrtf(ss * (1.f / 64.f) + EPSF) : 1.f;
                    h16* dst = kind == 0 ? base + (size_t)row * 512 + gi * 64 : base + ((size_t)((row >> 11) * 2 + g) * 2048 + (row & 2047)) * 64;
#pragma unroll
                    for (int bj = 0; bj < 2; ++bj) {
                        h16x8 o;
                        if (kind == 4 || kind == 6) {
                            bf16x8_t ob;
#pragma unroll
                            for (int n = 0; n < 2; ++n)
#pragma unroll
                                for (int i = 0; i < 4; ++i) ob[4 * n + i] = (__bf16)acc[ai][bj][m][n][i];
                            o = __builtin_bit_cast(h16x8, ob);
                        } else {
#pragma unroll
                            for (int n = 0; n < 2; ++n)
#pragma unroll
                                for (int i = 0; i < 4; ++i) o[4 * n + i] = (h16)(acc[ai][bj][m][n][i] * (rstd * qsc) * gv[bj][n][i]);
                        }
                        *(h16x8*)(dst + 32 * bj + 8 * fq) = o;
                    }
                }
        } else if (pn < 11) {
            h16* BCX = (h16*)(p.ws + WS_BCX);
#pragma unroll
            for (int ai = 0; ai < 2; ++ai)
#pragma unroll
                for (int m = 0; m < 4; ++m) {
                    const int row = u.pm * 256 + 128 * ai + 64 * wr + 16 * m + fr;
#pragma unroll
                    for (int bj = 0; bj < 2; ++bj) {
                        h16x8 o;
#pragma unroll
                        for (int n = 0; n < 2; ++n)
#pragma unroll
                            for (int i = 0; i < 4; ++i) o[4 * n + i] = (h16)acc[ai][bj][m][n][i];
                        *(h16x8*)(BCX + (size_t)row * 1536 + 256 * (pn - 5) + 128 * bj + 32 * wc + 8 * fq) = o;
                    }
                }
        } else {
            if (wc == 0 && fq < 3) {
                float* GA = (float*)(p.ws + WS_GATES);
#pragma unroll
                for (int ai = 0; ai < 2; ++ai)
#pragma unroll
                    for (int m = 0; m < 4; ++m) {
                        const int row = u.pm * 256 + 128 * ai + 64 * wr + 16 * m + fr;
#pragma unroll
                        for (int n = 0; n < 2; ++n) *(fg::f32x4*)(GA + (size_t)row * 24 + 8 * fq + 4 * n) = acc[ai][0][m][n];
                    }
            }
        }
    }
};
DEVI void ph_inproj_fast(const Params& P, unsigned char* lds_raw) {
    fg::Gemm g{(const h16*)(P.ws + WS_A1H), nullptr, (const h16*)(P.ws + WS_WIN), MTOK, 3072, 1024, 1024, (size_t)128 * 1024 * 2, 1024};
    fg::StaticOrder S; S.init(MTOK, 3072, gridDim.x, blockIdx.x);
    EF_inproj E{&P};
    fg::gemm_phase<EF_inproj>((FG_LAS unsigned char*)lds_raw, g, S, E);
}

constexpr size_t WS_SH2H = 140 * MiB;
constexpr size_t WS_HIDP = 104 * MiB;
struct EF_compress {
    static constexpr bool PERM = false;
    const Params* P;
    DEVI void operator()(const fg::f32x4 (&acc)[2][2][4][2], const fg::Unit& u, int wr, int wc, int fr, int fq) const {
        const Params& p = *P;
        float* HID = (float*)(p.ws + WS_HIDP) + (size_t)(u.pn >> 1) * 4096 * 512 + 256 * (u.pn & 1);
#pragma unroll
        for (int bj = 0; bj < 2; ++bj)
#pragma unroll
            for (int n = 0; n < 2; ++n) {
                const int col = 128 * bj + 32 * wc + 16 * n + 4 * fq;
#pragma unroll
                for (int ai = 0; ai < 2; ++ai)
#pragma unroll
                    for (int m = 0; m < 4; ++m) {
                        const int row = u.pm * 256 + 128 * ai + 64 * wr + 16 * m + fr;
                        *(fg::f32x4*)(HID + (size_t)row * 512 + col) = acc[ai][bj][m][n];
                    }
            }
    }
};
DEVI void ph_compress_fast(const Params& P, unsigned char* lds_raw) {
    fg::Gemm g{(const h16*)(P.ws + WS_KCH), (const h16*)(P.ws + WS_VC), (const h16*)(P.ws + WS_WC1), 4096, 2048, 512, 1024, (size_t)2048 * 64 * 2, 2048};
    fg::StaticOrder S; S.init(4096, 2048, gridDim.x, blockIdx.x);
    EF_compress E{&P};
    fg::gemm_phase<EF_compress>((FG_LAS unsigned char*)lds_raw, g, S, E);
}
struct EF_bias13 {
    static constexpr bool PERM = true;
    const Params* P;
    DEVI void operator()(const fg::f32x4 (&acc)[2][2][4][2], const fg::Unit& u, int wr, int wc, int fr, int fq) const {
        if (wr != 0) return;
        float* bias13 = (float*)(P->ws + WS_BIAS13) + fr * 5632 + 128 * u.pn + 32 * wc + 8 * fq;
#pragma unroll
        for (int n = 0; n < 2; ++n) { *(fg::f32x4*)(bias13 + 4 * n) = acc[0][0][0][n]; *(fg::f32x4*)(bias13 + 2816 + 4 * n) = acc[0][1][0][n]; }
    }
};
DEVI void ph_bias13_gemm(const Params& P, unsigned char* lds_raw) {
    fg::Gemm g{(const h16*)(P.ws + WS_SH2H), nullptr, (const h16*)(P.ws + WS_W13), 256, 5632, 1024, 1024, (size_t)128 * 1024 * 2, 1024};
    fg::StaticOrder S; S.init(256, 5632, 22, (int)blockIdx.x - 128);
    EF_bias13 E{&P};
    fg::gemm_phase<EF_bias13>((FG_LAS unsigned char*)lds_raw, g, S, E);
}
constexpr size_t WS_MODP = 144 * MiB;
constexpr size_t WS_POSBP = 9 * MiB + 64 * 1024;
DEVI void fma16(float (&acc)[16], const float* s, float w) {
    const float4 s0 = *(const float4*)(s), s1 = *(const float4*)(s + 4), s2 = *(const float4*)(s + 8), s3 = *(const float4*)(s + 12);
    acc[0] += s0.x * w; acc[1] += s0.y * w; acc[2] += s0.z * w; acc[3] += s0.w * w; acc[4] += s1.x * w; acc[5] += s1.y * w; acc[6] += s1.z * w; acc[7] += s1.w * w;
    acc[8] += s2.x * w; acc[9] += s2.y * w; acc[10] += s2.z * w; acc[11] += s2.w * w; acc[12] += s3.x * w; acc[13] += s3.y * w; acc[14] += s3.z * w; acc[15] += s3.w * w;
}
DEVI void ph_prep2(const Params& P, float* lds) {
    const int tid = threadIdx.x, blk = blockIdx.x;
    const int lane = tid & 63, wv = tid >> 6;
    if (gridDim.x == 256 ? blk < 192 : true) {
        for (int task = blk; task < 192; task += (gridDim.x == 256 ? 192 : gridDim.x)) {
            const int ks = task & 15, jc = task >> 4;
            float* sT = lds;
            __syncthreads();
            for (int i = tid; i < 1024; i += 512) { const int kk = i >> 4, b = i & 15; sT[i] = siluf(P.c[b * 1024 + ks * 64 + kk]); }
            __syncthreads();
            const int j = jc * 512 + tid;
            float acc[16];
#pragma unroll
            for (int b = 0; b < 16; ++b) acc[b] = 0.f;
            const float* w = P.w_ada + (size_t)(ks * 64) * 6144 + j;
#pragma unroll 1
            for (int k0 = 0; k0 < 64; k0 += 32) {
                float wv32[32];
#pragma unroll
                for (int kk = 0; kk < 32; ++kk) wv32[kk] = w[(size_t)(k0 + kk) * 6144];
#pragma unroll
                for (int kk = 0; kk < 32; ++kk) { fma16(acc, sT + (k0 + kk) * 16, wv32[kk]); if ((kk & 3) == 3) __builtin_amdgcn_sched_barrier(0); }
            }
            float* modp = (float*)(P.ws + WS_MODP);
#pragma unroll
            for (int b = 0; b < 16; ++b) modp[(size_t)(ks * 16 + b) * 6144 + j] = acc[b];
        }
        __syncthreads();
    }
    if (gridDim.x == 256 ? blk >= 192 : true) {
        for (int ks = (gridDim.x == 256 ? blk - 192 : blk); ks < 64; ks += (gridDim.x == 256 ? 64 : gridDim.x)) {
            const int which = tid >> 8, j = tid & 255;
            const float* w1 = (which ? P.w_cv1 : P.w_ck1) + (size_t)(ks * 32) * 256 + j;
            const float* pos = (which ? P.cmp_pos_v : P.cmp_pos_k) + ks * 32;
            float wv32[32], acc = 0.f;
#pragma unroll
            for (int kk = 0; kk < 32; ++kk) wv32[kk] = w1[(size_t)kk * 256];
#pragma unroll
            for (int kk = 0; kk < 32; ++kk) acc += pos[kk] * wv32[kk];
            ((float*)(P.ws + WS_POSBP))[ks * 512 + tid] = acc;
        }
    }
    float* scr = lds + wv * 4096;
    constexpr int I_IN = 16 * 96, I_OUT = 16 * 32, I_13 = 16 * 176, I_2 = 44 * 32, I_C = 32 * 16, NIT = I_IN + I_OUT + I_13 + I_2 + I_C;
    int it0, its, ite;
    if (gridDim.x == 256) { if (blk < 192) { it0 = blk * 8 + wv; its = 1536; ite = 4608; } else { it0 = 4608 + (blk - 192) * 8 + wv; its = 512; ite = NIT; } }
    else { it0 = blk * 8 + wv; its = gridDim.x * 8; ite = NIT; }
    for (int it = it0; it < ite; it += its) {
        int r = it;
        if (r < I_IN) { transpose_item(SrcWin{P.w_in}, 1024, (h16*)(P.ws + WS_WIN), scr, r, 96, lane); continue; } r -= I_IN;
        if (r < I_OUT) { transpose_item(SrcWout{P.w_out, P.attn_out_gain, P.conv_out_gain}, 1024, (h16*)(P.ws + WS_WOUT), scr, r, 32, lane); continue; } r -= I_OUT;
        if (r < I_13) { transpose_item(SrcW13{P.w_ff1, P.w_ff3}, 1024, (h16*)(P.ws + WS_W13), scr, r, 176, lane); continue; } r -= I_13;
        if (r < I_2) { transpose_item(SrcW2{P.w_ff2}, DFF, (h16*)(P.ws + WS_W2), scr, r, 32, lane); continue; } r -= I_2;
        transpose_item(SrcWc1{P.w_ck1, P.w_cv1}, 2048, (h16*)(P.ws + WS_WC1), scr, r, 16, lane);
    }
}
DEVI void ph_norm1_2(const Params& P, float* lds) {
    const int tid = threadIdx.x, lane = tid & 63, wv = tid >> 6, blk = blockIdx.x;
    const float* modp = (const float*)(P.ws + WS_MODP);
    float* mod = (float*)(P.ws + WS_MOD);
    h16* A1H = (h16*)(P.ws + WS_A1H);
    for (int rg = blk; rg < 256; rg += gridDim.x) {
        const int b = rg >> 4, sl = rg & 15;
        float* ms = lds;
        {
            float v4[4];
#pragma unroll
            for (int q = 0; q < 4; ++q) v4[q] = P.b_ada[tid + 512 * q];
#pragma unroll
            for (int ks = 0; ks < 16; ++ks)
#pragma unroll
                for (int q = 0; q < 4; ++q) v4[q] += modp[(size_t)(ks * 16 + b) * 6144 + tid + 512 * q];
#pragma unroll
            for (int q = 0; q < 4; ++q) ms[tid + 512 * q] = v4[q];
        }
        if (tid < 384) { const int j = sl * 384 + tid; float v = P.b_ada[j];
#pragma unroll
            for (int ks = 0; ks < 16; ++ks) v += modp[(size_t)(ks * 16 + b) * 6144 + j];
            mod[b * 6144 + j] = v;
            if (j >= 3072 && j < 4096) ((h16*)(P.ws + WS_SH2H))[b * 1024 + j - 3072] = (h16)v; }
        __syncthreads();
        for (int r = wv * 16; r < wv * 16 + 16; r += 8) {
            float4 v[8][4];
#pragma unroll
            for (int rr = 0; rr < 8; ++rr) { const float* xr = P.x + (size_t)(rg * 128 + r + rr) * 1024;
#pragma unroll
                for (int j = 0; j < 4; ++j) { const fg::f32x4 t = __builtin_nontemporal_load((const fg::f32x4*)(xr + 256 * j + 4 * lane)); v[rr][j] = make_float4(t[0], t[1], t[2], t[3]); } }
#pragma unroll
            for (int rr = 0; rr < 8; ++rr) {
                const int row = rg * 128 + r + rr;
                float s = 0.f;
#pragma unroll
                for (int j = 0; j < 4; ++j) s += v[rr][j].x * v[rr][j].x + v[rr][j].y * v[rr][j].y + v[rr][j].z * v[rr][j].z + v[rr][j].w * v[rr][j].w;
                const float rstd = rsqrtf(wsum(s) * (1.f / 1024.f) + EPSF);
#pragma unroll
                for (int j = 0; j < 4; ++j) {
                    const int k = 256 * j + 4 * lane;
                    const float4 g = *(const float4*)(P.norm1_gain + k);
                    const float4 sh = *(const float4*)(ms + k);
                    const float4 sc = *(const float4*)(ms + 1024 + k);
                    h16x4 hi;
                    hi[0] = (h16)(v[rr][j].x * rstd * g.x * (1.f + sc.x) + sh.x);
                    hi[1] = (h16)(v[rr][j].y * rstd * g.y * (1.f + sc.y) + sh.y);
                    hi[2] = (h16)(v[rr][j].z * rstd * g.z * (1.f + sc.z) + sh.z);
                    hi[3] = (h16)(v[rr][j].w * rstd * g.w * (1.f + sc.w) + sh.w);
                    *(h16x4*)(A1H + (size_t)row * 1024 + k) = hi;
                }
            }
        }
        __syncthreads();
    }
    if (blk == 88) {
        const float* pp = (const float*)(P.ws + WS_POSBP);
        float v = 0.f;
#pragma unroll
        for (int ks = 0; ks < 64; ++ks) v += pp[ks * 512 + tid];
        ((float*)(P.ws + WS_POSB))[tid] = v;
    }
}
constexpr int CW_CONVQ = 64;
DEVI void ph_conv2(const Params& P, float* lds) {
    const int lane = threadIdx.x & 63, wv = threadIdx.x >> 6;
    const h16* BCX = (const h16*)(P.ws + WS_BCX);
    h16* Y = (h16*)(P.ws + WS_Y);
    unsigned* ticket = (unsigned*)(P.ws + WS_CTL) + CW_CONVQ;
    volatile unsigned* slot = (volatile unsigned*)lds;
    const int c = lane * 8;
    float cw[3][8];
#pragma unroll
    for (int k = 0; k < 3; ++k)
#pragma unroll
        for (int i = 0; i < 8; ++i) cw[k][i] = P.conv_w[k * 512 + c + i];
    for (;;) {
        __syncthreads();
        if (threadIdx.x == 0) slot[0] = __hip_atomic_fetch_add(ticket, 1u, __ATOMIC_RELAXED, __HIP_MEMORY_SCOPE_AGENT);
        __syncthreads();
        const unsigned chunk = slot[0];
        if (chunk >= MTOK / 64) break;
        const int rowb = chunk * 64 + wv * 8, tb = rowb & 2047;
        const h16* rb = BCX + (size_t)rowb * 1536;
        float um1[8], um2[8];
        {
            h16x8 ca = {}, xa = {}, cb = {}, xb = {};
            if (tb >= 1) { ca = *(const h16x8*)(rb - 1536 + 512 + c); xa = *(const h16x8*)(rb - 1536 + 1024 + c); }
            if (tb >= 2) { cb = *(const h16x8*)(rb - 3072 + 512 + c); xb = *(const h16x8*)(rb - 3072 + 1024 + c); }
#pragma unroll
            for (int i = 0; i < 8; ++i) { um1[i] = (float)ca[i] * (float)xa[i]; um2[i] = (float)cb[i] * (float)xb[i]; }
        }
#pragma unroll
        for (int half = 0; half < 2; ++half) {
            h16x8 bgv[4], cv[4], xv[4];
#pragma unroll
            for (int j = 0; j < 4; ++j) { const h16* r2 = rb + (size_t)(half * 4 + j) * 1536; bgv[j] = *(const h16x8*)(r2 + c); cv[j] = *(const h16x8*)(r2 + 512 + c); xv[j] = *(const h16x8*)(r2 + 1024 + c); }
#pragma unroll
            for (int j = 0; j < 4; ++j) {
                float y[8], ssq = 0.f;
#pragma unroll
                for (int i = 0; i < 8; ++i) {
                    const float u0 = (float)cv[j][i] * (float)xv[j][i];
                    y[i] = (float)bgv[j][i] * (um2[i] * cw[0][i] + um1[i] * cw[1][i] + u0 * cw[2][i]);
                    um2[i] = um1[i]; um1[i] = u0;
                    ssq += y[i] * y[i];
                }
                const float rstd = rsqrtf(wsum(ssq) * (1.f / 512.f) + EPSF);
                h16x8 o;
#pragma unroll
                for (int i = 0; i < 8; ++i) o[i] = (h16)(y[i] * rstd);
                *(h16x8*)(Y + (size_t)(rowb + half * 4 + j) * 1024 + 512 + c) = o;
            }
        }
    }
}
DEVI void ph_compress2b(const Params& P, float* lds) {
    const int tid = threadIdx.x, lane = tid & 63, wv = tid >> 6;
    const int which = blockIdx.x & 1, nbw = (gridDim.x + 1 - which) >> 1, bw = blockIdx.x >> 1;
    const float* w2 = which ? P.w_cv2 : P.w_ck2;
    for (int i = tid; i < 4096; i += 512) *(float4*)(lds + 4 * i) = *(const float4*)(w2 + 4 * i);
    __syncthreads();
    const float* HID = (const float*)(P.ws + WS_HIDP);
    const float* posb = (const float*)(P.ws + WS_POSB);
    h16* dst = (h16*)(P.ws + (which ? WS_VCC : WS_KCNH));
    const float gain = P.k_cmp_gain[lane];
    for (int r = bw * 8 + wv; r < 4096; r += nbw * 8) {
        float o = 0.f;
        if ((r & 127) < 127) {
            float4 h4 = *(const float4*)(posb + 256 * which + 4 * lane);
#pragma unroll
            for (int ks = 0; ks < 4; ++ks) { const float4 t = *(const float4*)(HID + (size_t)ks * 4096 * 512 + (size_t)r * 512 + 256 * which + 4 * lane); h4.x += t.x; h4.y += t.y; h4.z += t.z; h4.w += t.w; }
            h4.x = silu_fast(h4.x); h4.y = silu_fast(h4.y); h4.z = silu_fast(h4.z); h4.w = silu_fast(h4.w);
#pragma unroll
            for (int jj = 0; jj < 64; ++jj) {
                o += __builtin_bit_cast(float, __builtin_amdgcn_readlane(__builtin_bit_cast(int, h4.x), jj)) * lds[(4 * jj + 0) * 64 + lane];
                o += __builtin_bit_cast(float, __builtin_amdgcn_readlane(__builtin_bit_cast(int, h4.y), jj)) * lds[(4 * jj + 1) * 64 + lane];
                o += __builtin_bit_cast(float, __builtin_amdgcn_readlane(__builtin_bit_cast(int, h4.z), jj)) * lds[(4 * jj + 2) * 64 + lane];
                o += __builtin_bit_cast(float, __builtin_amdgcn_readlane(__builtin_bit_cast(int, h4.w), jj)) * lds[(4 * jj + 3) * 64 + lane];
            }
            if (which == 0) o = o * rsqrtf(wsum(o * o) * (1.f / 64.f) + EPSF) * gain;
        }
        if (which) { const __bf16 ob = (__bf16)o; dst[(size_t)r * 64 + lane] = __builtin_bit_cast(h16, ob); } else dst[(size_t)r * 64 + lane] = (h16)o;
    }
}

namespace fa {
#define FA_LAS __attribute__((address_space(3)))
typedef float f32x16 __attribute__((ext_vector_type(16)));
typedef short s16x4 __attribute__((ext_vector_type(4)));
typedef short s16x8 __attribute__((ext_vector_type(8)));
constexpr float LOG2E = 1.4426950408889634f, NEGBIG = -30000.f, THR = 8.f;
constexpr int STAGE_B = 32768, L_BIAS = 65536, L_OT = 69632  , L_SLAB = 69632,
              L_SELM = 135168, L_SSQ = 135424, L_CB = 141568, OST_PITCH = 1040;

struct TileSrc { const h16 *k0, *k1, *v0, *v1; };
struct WaveCtx { int hi; int koff[4]; int voff; int dk, dv; FA_LAS const float* brow; };
DEVI void tile_dma(const TileSrc& S, int key0, FA_LAS unsigned char* st, const WaveCtx& W, int wv) {
    const size_t ko = (size_t)key0 * 64 + W.dk, vo = (size_t)key0 * 64 + W.dv;
    __builtin_amdgcn_global_load_lds((const unsigned*)(S.k0 + ko), (FA_LAS unsigned*)(st + wv * 1024), 16, 0, 0);
    __builtin_amdgcn_global_load_lds((const unsigned*)(S.k1 + ko), (FA_LAS unsigned*)(st + 8192 + wv * 1024), 16, 0, 0);
    __builtin_amdgcn_global_load_lds((const unsigned*)(S.v0 + vo), (FA_LAS unsigned*)(st + 16384 + wv * 1024), 16, 0, 0);
    __builtin_amdgcn_global_load_lds((const unsigned*)(S.v1 + vo), (FA_LAS unsigned*)(st + 24576 + wv * 1024), 16, 0, 0);
}
DEVI float max3f(float a, float b, float c) { float r; asm("v_max3_f32 %0, %1, %2, %3" : "=v"(r) : "v"(a), "v"(b), "v"(c)); return r; }

template <bool LOOKUP, bool EMASK, int RELMUL, int PSB>
DEVI void tile_step(FA_LAS const unsigned char* Kt, FA_LAS const unsigned char* Vt, const WaveCtx& W, const h16x8 (&qf)[4], f32x16 (&O)[2], float& mhat, float& lsum,
                    float cinit, int relb, int klo, int khi, f32x16& pA, f32x16& pB) {
    f32x16 p0, p1;
    {
        h16x8 kf[8];
#pragma unroll
        for (int s = 0; s < 4; ++s) { kf[2 * s] = *(FA_LAS const h16x8*)(Kt + W.koff[s]); kf[2 * s + 1] = *(FA_LAS const h16x8*)(Kt + 4096 + W.koff[s]); }
#pragma unroll
        for (int r = 0; r < 16; ++r) { p0[r] = cinit; p1[r] = cinit; }
        __builtin_amdgcn_sched_barrier(0);
        __builtin_amdgcn_s_setprio(1);
        p0 = __builtin_amdgcn_mfma_f32_32x32x16_f16(kf[0], qf[0], p0, 0, 0, 0);
        p1 = __builtin_amdgcn_mfma_f32_32x32x16_f16(kf[1], qf[0], p1, 0, 0, 0);
#pragma unroll
        for (int s = 1; s < 4; ++s) {
            p0 = __builtin_amdgcn_mfma_f32_32x32x16_f16(kf[2 * s], qf[s], p0, 0, 0, 0);
            p1 = __builtin_amdgcn_mfma_f32_32x32x16_f16(kf[2 * s + 1], qf[s], p1, 0, 0, 0);
        }
        __builtin_amdgcn_s_setprio(0);
    }
    const unsigned vb = (unsigned)(uintptr_t)Vt + (unsigned)W.voff;
    s16x4 vlo[8], vhi[8];
#pragma unroll
    for (int i = 0; i < 8; ++i) {
        asm volatile("ds_read_b64_tr_b16 %0, %1 offset:%c2" : "=&v"(vlo[i]) : "v"(vb), "i"((i >> 2) * 4096 + ((i >> 1) & 1) * 2048 + (i & 1) * 256) : "memory");
        asm volatile("ds_read_b64_tr_b16 %0, %1 offset:%c2" : "=&v"(vhi[i]) : "v"(vb), "i"((i >> 2) * 4096 + ((i >> 1) & 1) * 2048 + (i & 1) * 256 + 1024) : "memory");
    }
    if (LOOKUP) {
        const int relh = relb - RELMUL * 4 * W.hi;
#pragma unroll
        for (int r = 0; r < 16; ++r) {
            const int kc = (r & 3) + 8 * (r >> 2);
            int i0 = relh - RELMUL * kc;
            i0 = i0 < 0 ? 0 : (i0 > 127 ? 127 : i0);
            p0[r] += W.brow[i0];
        }
        __builtin_amdgcn_sched_barrier(0);
#pragma unroll
        for (int r = 0; r < 16; ++r) {
            const int kc = (r & 3) + 8 * (r >> 2);
            int i1 = relh - RELMUL * (kc + 32);
            i1 = i1 < 0 ? 0 : (i1 > 127 ? 127 : i1);
            p1[r] += W.brow[i1];
        }
    }
    if (EMASK) {
        const int kl = klo - 4 * W.hi, kh = khi - 4 * W.hi;
#pragma unroll
        for (int r = 0; r < 16; ++r) {
            const int kc = (r & 3) + 8 * (r >> 2);
            p0[r] = (kc >= kl && kc <= kh) ? p0[r] : NEGBIG;
            p1[r] = (kc + 32 >= kl && kc + 32 <= kh) ? p1[r] : NEGBIG;
        }
    }
    float sacc = 0.f, sacc1 = 0.f;
#pragma unroll
    for (int r = 0; r < 16; ++r) { p0[r] = __builtin_amdgcn_exp2f(p0[r]); p1[r] = __builtin_amdgcn_exp2f(p1[r]); sacc += p0[r]; asm("" : "+v"(sacc)); sacc1 += p1[r]; asm("" : "+v"(sacc1)); }
    lsum += sacc + sacc1;
    if (PSB >= 0) {
#pragma unroll
        for (int g4 = 0; g4 < 4; ++g4) {
            pA[PSB + g4] += 2.f * (p0[4 * g4] + p0[4 * g4 + 1] + p0[4 * g4 + 2]) + p0[4 * g4 + 3]; pB[PSB + g4] += p0[4 * g4 + 3];
            pA[PSB + 4 + g4] += 2.f * (p1[4 * g4] + p1[4 * g4 + 1] + p1[4 * g4 + 2]) + p1[4 * g4 + 3]; pB[PSB + 4 + g4] += p1[4 * g4 + 3];
        }
    }
    bf16x8_t pk[4];
#pragma unroll
    for (int kk = 0; kk < 4; ++kk)
#pragma unroll
        for (int j = 0; j < 8; ++j) pk[kk][j] = (__bf16)((kk >> 1) ? p1[8 * (kk & 1) + j] : p0[8 * (kk & 1) + j]);
    asm volatile("s_waitcnt lgkmcnt(0)" : "+v"(vlo[0]), "+v"(vhi[0]), "+v"(vlo[1]), "+v"(vhi[1]), "+v"(vlo[2]), "+v"(vhi[2]), "+v"(vlo[3]), "+v"(vhi[3]),
                 "+v"(vlo[4]), "+v"(vhi[4]), "+v"(vlo[5]), "+v"(vhi[5]), "+v"(vlo[6]), "+v"(vhi[6]), "+v"(vlo[7]), "+v"(vhi[7]) :: "memory");
    __builtin_amdgcn_sched_barrier(0);
    __builtin_amdgcn_s_setprio(1);
#pragma unroll
    for (int i = 0; i < 8; ++i) {
        const s16x8 v8 = {vlo[i][0], vlo[i][1], vlo[i][2], vlo[i][3], vhi[i][0], vhi[i][1], vhi[i][2], vhi[i][3]};
        O[i & 1] = __builtin_amdgcn_mfma_f32_32x32x16_bf16(__builtin_bit_cast(bf16x8_t, v8), pk[i >> 1], O[i & 1], 0, 0, 0);
    }
    __builtin_amdgcn_s_setprio(0);
}

DEVI unsigned wave_or(unsigned v) {
#pragma unroll
    for (int o = 1; o < 64; o <<= 1) v |= (unsigned)__shfl_xor((int)v, o);
    return v;
}

template <int MODE>
DEVI void branch_loop(unsigned tmask, const TileSrc& S, FA_LAS unsigned char* lds, const WaveCtx& W, const h16x8 (&qf)[4], f32x16 (&O)[2], float& mhat, float& lsum,
                      int g, int wv, int tq, int bt, int jlo, unsigned lmask, unsigned gunion) {
    f32x16 dA, dB;
    int jb = __builtin_ctz(tmask); tmask &= tmask - 1;
    tile_dma(S, 64 * jb, lds, W, wv);
    __syncthreads();
    int cur = 0;
    const float b31 = W.brow[127];
#pragma unroll 1
    for (;;) {
        const int nj = tmask ? __builtin_ctz(tmask) : -1;
        if (nj >= 0) { tmask &= tmask - 1; tile_dma(S, 64 * nj, lds + (cur ^ 1) * STAGE_B, W, wv); }
        FA_LAS const unsigned char* st = lds + cur * STAGE_B;
        FA_LAS const unsigned char* Kt = st + g * 8192;
        FA_LAS const unsigned char* Vt = st + 16384 + g * 8192;
        const bool lookup = (jb + 2 >= bt);
        const int relb = tq - 64 * jb;
        if (MODE == 1) {
            if ((gunion >> jb) & 1u) {
                const bool sel = (lmask >> jb) & 1u;
                if (jb == bt) tile_step<true, true, 1, -1>(Kt, Vt, W, qf, O, mhat, lsum, sel ? -mhat : NEGBIG, relb, -1000, relb, dA, dB);
                else if (lookup) tile_step<true, false, 1, -1>(Kt, Vt, W, qf, O, mhat, lsum, sel ? -mhat : NEGBIG, relb, 0, 0, dA, dB);
                else tile_step<false, false, 1, -1>(Kt, Vt, W, qf, O, mhat, lsum, sel ? b31 - mhat : NEGBIG, relb, 0, 0, dA, dB);
            }
        } else {
            const bool emask = (jb == bt) || (jb == jlo);
            if (lookup) {
                if (emask) tile_step<true, true, 1, -1>(Kt, Vt, W, qf, O, mhat, lsum, -mhat, relb, relb - 511, relb, dA, dB);
                else tile_step<true, false, 1, -1>(Kt, Vt, W, qf, O, mhat, lsum, -mhat, relb, 0, 0, dA, dB);
            } else {
                if (emask) tile_step<false, true, 1, -1>(Kt, Vt, W, qf, O, mhat, lsum, b31 - mhat, relb, relb - 511, relb, dA, dB);
                else tile_step<false, false, 1, -1>(Kt, Vt, W, qf, O, mhat, lsum, b31 - mhat, relb, 0, 0, dA, dB);
            }
        }
        __syncthreads();
        if (nj < 0) break;
        jb = nj; cur ^= 1;
    }
}

DEVI void attn_unit(const Params& P, FA_LAS unsigned char* lds, int b, int qt) {
    const int tid = threadIdx.x, lane = tid & 63, wv = __builtin_amdgcn_readfirstlane(tid >> 6), hi = lane >> 5, q = lane & 31, g = wv >> 2;
    const int q0 = 32 * qt, bt = q0 >> 6, tq = q0 + q, row0 = b * 2048 + q0;
    WaveCtx W; W.hi = hi;
    { const int x = (q >> 1) & 7;
#pragma unroll
      for (int s = 0; s < 4; ++s) W.koff[s] = q * 128 + (((2 * s + hi) ^ x) * 16); }
    W.voff = hi * 512 + ((lane >> 4) & 1) * 128 + ((lane & 15) >> 2) * 32 + (lane & 3) * 8;
    W.dk = (8 * wv + (lane >> 3)) * 64 + (((lane & 7) ^ ((4 * wv + (lane >> 4)) & 7)) * 8);
    W.dv = (8 * wv + 4 * (lane >> 5) + ((lane & 7) >> 1)) * 64 + ((lane >> 3) & 3) * 16 + (lane & 1) * 8;
    W.brow = (FA_LAS const float*)(lds + L_BIAS) + wv * 128;
    FA_LAS float* OtL = (FA_LAS float*)(lds + L_OT) + wv * 2048 + lane;
    const h16* QH = (const h16*)(P.ws + WS_QH);
    h16x8 qf[4];
#pragma unroll
    for (int s = 0; s < 4; ++s) qf[s] = *(const h16x8*)(QH + (size_t)(row0 + q) * 512 + wv * 64 + 16 * s + 8 * hi);
    FA_LAS float* gts = (FA_LAS float*)(lds + L_SSQ + 1024) + wv * 96;
    if (hi == 0) { const float* gl = (const float*)(P.ws + WS_GATES) + (size_t)(row0 + q) * 24 + wv * 3; gts[q] = sigm_fast(gl[0]); gts[32 + q] = sigm_fast(gl[1]); gts[64 + q] = sigm_fast(gl[2]); }
    unsigned lmask = (2u << bt) - 1u, gunion = lmask, uall = lmask;
    {
        const size_t cb = (size_t)b * 2 * 128 * 64;
        TileSrc S{(const h16*)(P.ws + WS_KCNH) + cb, (const h16*)(P.ws + WS_KCNH) + cb + 128 * 64, (const h16*)(P.ws + WS_VCC) + cb, (const h16*)(P.ws + WS_VCC) + cb + 128 * 64};
        const bool two = (q0 >> 4) >= 64;
        tile_dma(S, 0, lds, W, wv);
        if (two) tile_dma(S, 64, lds + STAGE_B, W, wv);
        __syncthreads();
        f32x16 O[2], pA, pB;
#pragma unroll
        for (int r = 0; r < 16; ++r) { O[0][r] = 0.f; O[1][r] = 0.f; pA[r] = 0.f; pB[r] = 0.f; }
        float mhat = ((FA_LAS const float*)(lds + L_CB))[wv], lsum = 0.f;
        const int nq = tq >= 31 ? (tq - 31) >> 4 : -1;
        tile_step<true, true, 16, 0>(lds + g * 8192, lds + 16384 + g * 8192, W, qf, O, mhat, lsum, -mhat, tq - 31, -1000, nq, pA, pB);
        if (two) tile_step<true, true, 16, 8>(lds + STAGE_B + g * 8192, lds + STAGE_B + 16384 + g * 8192, W, qf, O, mhat, lsum, -mhat, tq - 31 - 1024, -1000, nq - 64, pA, pB);
        const float lt = lsum + __shfl_xor(lsum, 32);
        const float inv = lt > 0.f ? 1.f / lt : 0.f;
        const float sc = gts[q] * inv;
#pragma unroll
        for (int r = 0; r < 16; ++r) { O[0][r] *= sc; O[1][r] *= sc; }
        if (bt >= 16) {
            FA_LAS float* slab = (FA_LAS float*)(lds + L_SLAB) + (wv * 32 + q) * 32;
#pragma unroll
            for (int i = 0; i < 16; ++i) {
                const float a = pA[i] * inv, bv = pB[i] * inv;
                const float rc = __shfl_xor(bv, 32);
                float rp = 0.f;
                if (i > 0) rp = __shfl_xor(pB[i - 1] * inv, 32);
                slab[2 * i + hi] = a + (hi ? rc : rp);
            }
        }
        __syncthreads();
        if (bt >= 16) {
            FA_LAS const float* slabs = (FA_LAS const float*)(lds + L_SLAB);
            FA_LAS unsigned* selm = (FA_LAS unsigned*)(lds + L_SELM);
            int lane2 = threadIdx.x & 63; asm volatile("" : "+v"(lane2));
            const int j = lane2 & 31;
#pragma unroll 1
            for (int it = 0; it < 4; ++it) {
                const int rr = 8 * wv + 2 * it + (lane2 >> 5), gg = rr >> 5, qq = rr & 31;
                float sc2 = 0.f;
#pragma unroll
                for (int hh = 0; hh < 4; ++hh) sc2 += slabs[((gg * 4 + hh) * 32 + qq) * 32 + j];
                FA_LAS float* srow = (FA_LAS float*)(lds + 139520) + wv * 64 + (lane2 & 32);
                srow[j] = sc2;
                int rank = 0;
#pragma unroll
                for (int i4 = 0; i4 < 8; ++i4) {
                    const fg::f32x4 s4 = *(FA_LAS const fg::f32x4*)(srow + 4 * i4);
                    const float sv[4] = {s4[0], s4[1], s4[2], s4[3]};
#pragma unroll
                    for (int e = 0; e < 4; ++e) { const int i = 4 * i4 + e; rank += (i >= 1 && i <= bt - 2 && (sv[e] > sc2 || (sv[e] == sc2 && i < j))) ? 1 : 0; }
                }
                const bool forced = (j == 0 || j == bt || j == bt - 1), cand = (j >= 1 && j <= bt - 2);
                const bool sel = forced || (cand && rank < 13);
                const unsigned long long m64 = __ballot(sel);
                if (lane2 == 0) { selm[8 * wv + 2 * it] = (unsigned)m64; selm[8 * wv + 2 * it + 1] = (unsigned)(m64 >> 32); }
            }
            __syncthreads();
            lmask = selm[g * 32 + (lane2 & 31)];
            gunion = wave_or(lmask);
            uall = wave_or(selm[lane2]);
            gunion = __builtin_amdgcn_readfirstlane(gunion); uall = __builtin_amdgcn_readfirstlane(uall);
        }
#pragma unroll
        for (int r = 0; r < 16; ++r) { OtL[r * 64] = O[0][r]; OtL[(16 + r) * 64] = O[1][r]; }
    }
    {
        const size_t kb = (size_t)b * 2 * 2048 * 64;
        TileSrc S{(const h16*)(P.ws + WS_KS) + kb, (const h16*)(P.ws + WS_KS) + kb + 2048 * 64, (const h16*)(P.ws + WS_VS) + kb, (const h16*)(P.ws + WS_VS) + kb + 2048 * 64};
        f32x16 O[2];
#pragma unroll
        for (int r = 0; r < 16; ++r) { O[0][r] = 0.f; O[1][r] = 0.f; }
        float mhat = ((FA_LAS const float*)(lds + L_CB))[8 + wv], lsum = 0.f;
        branch_loop<1>(uall, S, lds, W, qf, O, mhat, lsum, g, wv, tq, bt, 0, lmask, gunion);
        const float lt = lsum + __shfl_xor(lsum, 32);
        const float sc = gts[32 + q] / lt;
#pragma unroll
        for (int r = 0; r < 16; ++r) { OtL[r * 64] += sc * O[0][r]; OtL[(16 + r) * 64] += sc * O[1][r]; }
    }
    {
        const size_t kb = (size_t)b * 2 * 2048 * 64;
        TileSrc S{(const h16*)(P.ws + WS_KW) + kb, (const h16*)(P.ws + WS_KW) + kb + 2048 * 64, (const h16*)(P.ws + WS_VW) + kb, (const h16*)(P.ws + WS_VW) + kb + 2048 * 64};
        f32x16 O[2];
#pragma unroll
        for (int r = 0; r < 16; ++r) { O[0][r] = 0.f; O[1][r] = 0.f; }
        float mhat = ((FA_LAS const float*)(lds + L_CB))[16 + wv], lsum = 0.f;
        const int jlo = q0 >= 511 ? (q0 - 511) >> 6 : 0;
        const unsigned wmask = ((2u << bt) - 1u) & ~((1u << jlo) - 1u);
        branch_loop<2>(wmask, S, lds, W, qf, O, mhat, lsum, g, wv, tq, bt, q0 >= 511 ? jlo : -1, 0u, 0u);
        const float lt = lsum + __shfl_xor(lsum, 32);
        const float sc = gts[64 + q] / lt;
        float ss = 0.f;
#pragma unroll
        for (int r = 0; r < 16; ++r) { O[0][r] = OtL[r * 64] + sc * O[0][r]; O[1][r] = OtL[(16 + r) * 64] + sc * O[1][r]; ss += O[0][r] * O[0][r] + O[1][r] * O[1][r]; }
        ss += __shfl_xor(ss, 32);
        int tid2 = threadIdx.x; asm volatile("" : "+v"(tid2));
        const int q2 = tid2 & 31, hi2 = (tid2 >> 5) & 1;
        FA_LAS float* ssq = (FA_LAS float*)(lds + L_SSQ);
        if (hi2 == 0) ssq[wv * 32 + q2] = ss;
        __syncthreads();
        float tot = 0.f;
#pragma unroll
        for (int w = 0; w < 8; ++w) tot += ssq[w * 32 + q2];
        const float rstd = rsqrtf(tot * (1.f / 512.f) + EPSF);
#pragma unroll
        for (int db = 0; db < 2; ++db)
#pragma unroll
            for (int g4 = 0; g4 < 4; ++g4) {
                h16x4 o;
#pragma unroll
                for (int i = 0; i < 4; ++i) o[i] = (h16)(O[db][4 * g4 + i] * rstd);
                *(FA_LAS h16x4*)(lds + q2 * OST_PITCH + (wv * 64 + 32 * db + 8 * g4 + 4 * hi2) * 2) = o;
            }
        __syncthreads();
        h16* Y = (h16*)(P.ws + WS_Y);
#pragma unroll
        for (int i = 0; i < 4; ++i) {
            const int cid = tid2 + 512 * i, rw = cid >> 6, cc = cid & 63;
            const h16x8 v = *(FA_LAS const h16x8*)(lds + rw * OST_PITCH + cc * 16);
            *(h16x8*)(Y + (size_t)(row0 + rw) * 1024 + cc * 8) = v;
        }
        __syncthreads();
    }
}

DEVI void attn_phase(const Params& P, unsigned char* lds_raw) {
    FA_LAS unsigned char* lds = (FA_LAS unsigned char*)lds_raw;
    FA_LAS float* bias = (FA_LAS float*)(lds + L_BIAS);
    for (int i = threadIdx.x; i < 8 * 128; i += 512) { const int h = i >> 7, n = i & 127; bias[i] = P.rel_bias[t5_bucket(n) * 8 + h] * LOG2E; }
    if (threadIdx.x < 24) {
        const int br = threadIdx.x >> 3, h = threadIdx.x & 7;
        const float* kg = br == 0 ? P.k_cmp_gain : br == 1 ? P.k_sel_gain : P.k_win_gain;
        float gq = 0.f, gk = 0.f, tb = 0.f;
        for (int d = 0; d < 64; ++d) { gq = fmaxf(gq, fabsf(P.q_gain[d])); gk = fmaxf(gk, fabsf(kg[d])); }
        for (int n = 0; n < 32; ++n) tb = fmaxf(tb, fabsf(P.rel_bias[n * 8 + h]));
        ((FA_LAS float*)(lds + L_CB))[threadIdx.x] = LOG2E * (8.f * gq * gk + tb) + 0.5f;
    }
    __syncthreads();
    if (gridDim.x == 256) {
        const int x = blockIdx.x & 7, m = blockIdx.x >> 3;
#pragma unroll 1
        for (int i = 0; i < 4; ++i) attn_unit(P, lds, 2 * x + (i >> 1), (i & 1) ? m : 63 - m);
    } else {
#pragma unroll 1
        for (int u = blockIdx.x; u < 1024; u += gridDim.x) attn_unit(P, lds, u >> 6, u & 63);
    }
}
}

#define LAS __attribute__((address_space(3)))
#define XB_TMO      128
#define XB_XCNT(j)  (256  + 64 * (j))
#define XB_XSUB(j)  (1280 + 64 * (j))
#define XB_XGEN(j)  (2304 + 64 * (j))
#define XB_TOP      3328
#define XB_TOPGEN   3392
#define XCD_BAR_WORDS 3456
#define XB_SPIN_CAP (1u << 22)
__device__ __forceinline__ unsigned xb_ld(unsigned* p)              { return __hip_atomic_load(p, __ATOMIC_RELAXED, __HIP_MEMORY_SCOPE_AGENT); }
__device__ __forceinline__ unsigned xb_add(unsigned* p, unsigned v) { return __hip_atomic_fetch_add(p, v, __ATOMIC_RELAXED, __HIP_MEMORY_SCOPE_AGENT); }
__device__ __forceinline__ unsigned xb_xcc_id() { return (unsigned)__builtin_amdgcn_s_getreg((3 << 11) | 20) & 0xFu; }
#define XB_SPIN(cond, bar) do { unsigned _sp = 0; while (cond) { __builtin_amdgcn_s_sleep(1); \
    if ((++_sp & 255u) == 0u) { if (xb_ld(&(bar)[XB_TMO])) break; if (_sp > XB_SPIN_CAP) { atomicAdd(&(bar)[XB_TMO], 1u); break; } } } } while (0)
struct XcdBarrier { unsigned* bar; unsigned x; volatile LAS unsigned* st; };
__device__ __forceinline__ XcdBarrier xcd_barrier_post(unsigned* bar, volatile LAS unsigned* st) {
    XcdBarrier b; b.bar = bar; b.x = xb_xcc_id(); b.st = st;
    if (threadIdx.x == 0) (void)xb_add(&bar[XB_XCNT(b.x)], 1u);
    return b;
}
__device__ __forceinline__ void xcd_barrier_complete(unsigned* bar, unsigned x, unsigned& nloc, unsigned& nx) {
    const unsigned G = gridDim.x * gridDim.y * gridDim.z;
    unsigned sum, cnt, mine, sp = 0u;
    for (;;) {
        sum = 0u; cnt = 0u; mine = 0u;
#pragma unroll
        for (unsigned j = 0; j < 16; ++j) { const unsigned c = xb_ld(&bar[XB_XCNT(j)]); sum += c; cnt += (c > 0u) ? 1u : 0u; mine = (j == x) ? c : mine; }
        if (sum == G) break;
        __builtin_amdgcn_s_sleep(1);
        if ((++sp & 255u) == 0u) { if (xb_ld(&bar[XB_TMO])) break; if (sp > XB_SPIN_CAP) { atomicAdd(&bar[XB_TMO], 1u); break; } }
    }
    nloc = mine > 0u ? mine : 1u; nx = cnt > 0u ? cnt : 1u;
}
__device__ __forceinline__ void xcd_barrier(const XcdBarrier& b) {
    asm volatile("s_waitcnt vmcnt(0)" ::: "memory");
    __syncthreads();
    if (threadIdx.x == 0) {
        unsigned* bar = b.bar;
        __builtin_amdgcn_s_waitcnt(0);
        unsigned nloc = b.st[0], nx = b.st[1];
        if (nloc == 0u) { xcd_barrier_complete(bar, b.x, nloc, nx); b.st[0] = nloc; b.st[1] = nx; }
        const unsigned old = xb_add(&bar[XB_XSUB(b.x)], 1u);
        const unsigned gen = old / nloc;
        if (old + 1u == (gen + 1u) * nloc) {
            __builtin_amdgcn_fence(__ATOMIC_RELEASE, "agent");
            asm volatile("s_waitcnt vmcnt(0)" ::: "memory");
            const unsigned og = xb_add(&bar[XB_TOP], 1u);
            const unsigned tg = og / nx;
            if (og + 1u == (tg + 1u) * nx) xb_add(&bar[XB_TOPGEN], 1u);
            else XB_SPIN(xb_ld(&bar[XB_TOPGEN]) == tg, bar);
            __builtin_amdgcn_fence(__ATOMIC_ACQUIRE, "agent");
            xb_add(&bar[XB_XGEN(b.x)], 1u);
            asm volatile("s_waitcnt vmcnt(0)" ::: "memory");
        } else {
            XB_SPIN(xb_ld(&bar[XB_XGEN(b.x)]) == gen, bar);
            __builtin_amdgcn_fence(__ATOMIC_ACQUIRE, "agent");
            asm volatile("s_waitcnt vmcnt(0)" ::: "memory");
        }
    }
    __syncthreads();
}

constexpr int LDS_BYTES = 147456;
constexpr int MISC_OFF = 147456 - 256;
constexpr size_t CTL_ZERO_BYTES = 64 * 1024;
constexpr int CW_BAR = 4096;
struct Args { Params P; int ph_lo, ph_hi, li, pad; };
__global__ void __launch_bounds__(512, 2) mega_fwd(Args a) {
    extern __shared__ __attribute__((aligned(16))) unsigned char lds_raw[];
    float* lds = (float*)lds_raw;
    const Params& P = a.P;
    volatile LAS unsigned* MISC = (volatile LAS unsigned*)((LAS unsigned char*)lds_raw + MISC_OFF);
    if (threadIdx.x < 32) MISC[threadIdx.x] = 0u;
    __syncthreads();
    XcdBarrier bar = xcd_barrier_post((unsigned*)(P.ws + WS_CTL) + CW_BAR + a.li * XCD_BAR_WORDS, MISC + 8);
    const int lo = a.ph_lo, hi = a.ph_hi;
#define IN(k) (lo <= (k) && (k) < hi)
#define SEAM(k) do { if (IN(k) && IN((k) + 1)) xcd_barrier(bar); } while (0)
#ifdef ONLY_ATTN
    fa::attn_phase(P, lds_raw); return;
#endif
    if (IN(0)) ph_prep2(P, lds);
    SEAM(0);
#ifdef PROBE_BARS
    for (int i = 0; i < PROBE_BARS; ++i) xcd_barrier(bar);
#endif
    if (IN(1)) ph_norm1_2(P, lds);
    SEAM(1);
    if (IN(2)) ph_inproj_fast(P, lds_raw);
    SEAM(2);
    if (IN(3)) { ph_compress_fast(P, lds_raw); if (blockIdx.x >= 128 && blockIdx.x < 150) ph_bias13_gemm(P, lds_raw); ph_conv2(P, lds); xcd_barrier(bar); ph_compress2b(P, lds); }
    SEAM(3);
    if (IN(4)) fa::attn_phase(P, lds_raw);
    SEAM(4);
    if (IN(5)) ph_outproj_fast(P, lds_raw);
    SEAM(5);
    if (IN(6)) ph_ffn1_fast(P, lds_raw);
    SEAM(6);
    if (IN(7)) ph_ffn2_fast(P, lds_raw);
#undef IN
#undef SEAM
}

#ifndef N_LAUNCHES
#define N_LAUNCHES 1
#endif
extern "C" void kernel_launch(void* const* d_in, const int* in_sizes, int n_in, void* d_out, int out_size, void* d_ws, size_t ws_size, hipStream_t stream) {
    static int grid = 0;
    if (grid == 0) {
        if (n_in != 25 || out_size != MTOK * DM || ws_size < WS_END) { fprintf(stderr, "kernel_launch: unexpected shapes n_in %d out %d ws %zu\n", n_in, out_size, ws_size); grid = -1; return; }
        int dev = 0, cus = 0, per_cu = 0;
        if (hipGetDevice(&dev) != hipSuccess || hipDeviceGetAttribute(&cus, hipDeviceAttributeMultiprocessorCount, dev) != hipSuccess) { grid = -1; return; }
        if (hipFuncSetAttribute((const void*)mega_fwd, hipFuncAttributeMaxDynamicSharedMemorySize, LDS_BYTES) != hipSuccess) { fprintf(stderr, "kernel_launch: hipFuncSetAttribute failed\n"); grid = -1; return; }
        if (hipOccupancyMaxActiveBlocksPerMultiprocessor(&per_cu, (const void*)mega_fwd, 512, LDS_BYTES) != hipSuccess || per_cu < 1) { fprintf(stderr, "kernel_launch: occupancy query says %d\n", per_cu); per_cu = 1; }
        (void)hipGetLastError();
        grid = cus;
    }
    if (grid < 0) return;
    (void)hipMemsetAsync((char*)d_ws + WS_CTL, 0, CTL_ZERO_BYTES, stream);
    Args a{};
    const float** pp = (const float**)&a.P;
    for (int i = 0; i < 25; ++i) pp[i] = (const float*)d_in[i];
    a.P.out = (float*)d_out;
    a.P.ws = (unsigned char*)d_ws;
#ifdef PROBE_TWICE
    { a.li = 0; a.ph_lo = 0; a.ph_hi = 8; hipLaunchKernelGGL(mega_fwd, dim3(grid), dim3(512), LDS_BYTES, stream, a);
      (void)hipMemsetAsync((char*)d_ws + WS_CTL, 0, 4096, stream);
      a.li = 1; hipLaunchKernelGGL(mega_fwd, dim3(grid), dim3(512), LDS_BYTES, stream, a); return; }
#endif
#ifdef PROBE_PH
    { const int k = PROBE_PH;
      a.ph_lo = 0; a.ph_hi = k + 1; hipLaunchKernelGGL(mega_fwd, dim3(grid), dim3(512), LDS_BYTES, stream, a);
      a.li = 1; a.ph_lo = k; a.ph_hi = k + 1; hipLaunchKernelGGL(mega_fwd, dim3(grid), dim3(512), LDS_BYTES, stream, a);
      a.li = 2; a.ph_lo = k + 1; a.ph_hi = 8; if (k + 1 < 8) hipLaunchKernelGGL(mega_fwd, dim3(grid), dim3(512), LDS_BYTES, stream, a); return; }
#endif
    if (N_LAUNCHES == 1) { a.ph_lo = 0; a.ph_hi = 8; hipLaunchKernelGGL(mega_fwd, dim3(grid), dim3(512), LDS_BYTES, stream, a); }
    else for (int ph = 0; ph < 8; ++ph) { a.ph_lo = ph; a.ph_hi = ph + 1; hipLaunchKernelGGL(mega_fwd, dim3(grid), dim3(512), LDS_BYTES, stream, a); }
}
```

```cpp
#include <hip/hip_runtime.h>
#include <cstdio>
#include <cstdint>

constexpr int DM = 1024, NB = 16, SEQ = 2048, MTOK = NB * SEQ, HD = 64, NH = 8;
constexpr int NPROJ = 2840, DFF = 2816, NCMP = 127;
constexpr float EPSF = 1e-6f;

typedef _Float16 h16;
typedef _Float16 h16x4 __attribute__((ext_vector_type(4)));
typedef _Float16 h16x8 __attribute__((ext_vector_type(8)));
typedef __bf16 bf16x8_t __attribute__((ext_vector_type(8)));

constexpr size_t MiB = 1u << 20;
constexpr size_t WS_CTL = 0;
constexpr size_t WS_MOD = 1 * MiB;
constexpr size_t WS_BIAS13 = 1 * MiB + 512 * 1024;
constexpr size_t WS_SSQ2 = 2 * MiB;
constexpr size_t WS_KCNH = 4 * MiB;
constexpr size_t WS_KCNL = 4 * MiB + 512 * 1024;
constexpr size_t WS_VCC = 5 * MiB;
constexpr size_t WS_GATES = 6 * MiB;
constexpr size_t WS_A1H = 40 * MiB, WS_A1L = 104 * MiB;
constexpr size_t WS_QH = 168 * MiB, WS_QL = 200 * MiB;
constexpr size_t WS_KCH = 232 * MiB, WS_KCL = 240 * MiB, WS_VC = 248 * MiB, WS_KS = 256 * MiB, WS_VS = 264 * MiB, WS_KW = 272 * MiB, WS_VW = 280 * MiB;
constexpr size_t WS_BCX = 292 * MiB;
constexpr size_t WS_Y = 40 * MiB;
constexpr size_t WS_A2 = 232 * MiB;
constexpr size_t WS_U = 296 * MiB;
constexpr size_t WS_U8 = 384 * MiB;
constexpr size_t WS_X1H = 168 * MiB;
constexpr size_t WS_B13P = 141 * MiB;
constexpr size_t WS_END = 472 * MiB;

struct Params {
    const float *x, *c, *w_ada, *b_ada, *norm1_gain, *w_in, *q_gain, *k_cmp_gain, *k_sel_gain, *k_win_gain, *cmp_pos_k, *cmp_pos_v,
        *w_ck1, *w_ck2, *w_cv1, *w_cv2, *rel_bias, *conv_w, *attn_out_gain, *conv_out_gain, *w_out, *norm2_gain, *w_ff1, *w_ff3, *w_ff2;
    float* out;
    unsigned char* ws;
};

#define DEVI __device__ __forceinline__

DEVI float wsum(float v) {
#pragma unroll
    for (int o = 32; o > 0; o >>= 1) v += __shfl_xor(v, o);
    return v;
}
DEVI float wmax(float v) {
#pragma unroll
    for (int o = 32; o > 0; o >>= 1) v = fmaxf(v, __shfl_xor(v, o));
    return v;
}
DEVI float siluf(float v) { return v / (1.f + expf(-v)); }
DEVI float sigmf(float v) { return 1.f / (1.f + expf(-v)); }
DEVI float sigm_fast(float v) { return __builtin_amdgcn_rcpf(1.f + __builtin_amdgcn_exp2f(-1.4426950408889634f * v)); }
DEVI float silu_fast(float v) { return v * sigm_fast(v); }
DEVI int t5_bucket(int n) {
    if (n < 16) return n;
    int large = 16 + (int)(logf((float)n / 16.f) / 2.0794415416798357f * 16.f);
    return large < 31 ? large : 31;
}

namespace fg {
#define FG_LAS __attribute__((address_space(3)))
typedef float f32x4 __attribute__((ext_vector_type(4)));
typedef unsigned u32x4 __attribute__((ext_vector_type(4)));
typedef unsigned u32x2 __attribute__((ext_vector_type(2)));
typedef int i32x4 __attribute__((ext_vector_type(4)));
typedef int i32x8 __attribute__((ext_vector_type(8)));
typedef long i64x2 __attribute__((ext_vector_type(2)));
constexpr int BM = 256, BK = 64, HALF = 128, HTB = HALF * BK * 2, STAGE_BYTES = 8 * HTB, NXCD = 8, WGM = 8;
__host__ __device__ __forceinline__ int lds_byte(int r, int c) { const int st = (r >> 4) * 2 + (c >> 5), rr = r & 15, cc = c & 31, ob = rr * 64 + cc * 2; return st * 1024 + (ob ^ (((ob >> 9) & 1) << 5)); }
__host__ __device__ __forceinline__ void stage_rc(int b, int& R, int& C) { const int st = b / 1024, sb = b % 1024, swz = sb ^ (((sb >> 9) & 1) << 5); R = (st >> 1) * 16 + swz / 64; C = (st & 1) * 32 + (swz % 64) / 2; }
__host__ __device__ __forceinline__ int perm32(int rho) { const int n = rho >> 4, i = rho & 15; return 8 * (i >> 2) + 4 * n + (i & 3); }
struct Unit { int pm, pn; };
struct Gemm {
    const h16* A; const h16* A2; const h16* Bt; int M, N, K, lda; size_t hstepA; int ldb; int nsplit = 1;
    DEVI const char* a_tile(const Unit& u) const { return A2 ? (const char*)((u.pn & 1) ? A2 : A) + (size_t)u.pm * 2 * hstepA + (size_t)(u.pn >> 1) * K * 2 : (const char*)A + (size_t)u.pm * 2 * hstepA + (size_t)(u.pn % nsplit) * K * 2; }
    DEVI const char* b_tile(const Unit& u) const { return A2 ? (const char*)Bt + (size_t)(u.pn & 1) * 2 * HALF * ldb * 2 + (size_t)(u.pn >> 1) * K * 2 : (const char*)Bt + (size_t)(u.pn / nsplit) * 2 * HALF * ldb * 2 + (size_t)(u.pn % nsplit) * K * 2; }
};
struct StaticOrder {
    int nM, nN, nwg, G, c;
    __host__ __device__ void init(int M, int N, int G_, int c_) { nM = M / BM; nN = N / BM; nwg = nM * nN; G = G_; c = c_; }
    __host__ __device__ bool next(int i, Unit& u) const {
        const long L = (long)i * G + c; if (L >= nwg) return false;
        int wgid = (int)L; { const int q = nwg / NXCD, r = nwg % NXCD, xcd = wgid % NXCD, off = wgid / NXCD; wgid = (xcd < r ? xcd * (q + 1) : r * (q + 1) + (xcd - r) * q) + off; }
        const int nig = WGM * nN, gid = wgid / nig, fm = gid * WGM, gsz = (nM - fm) < WGM ? (nM - fm) : WGM;
        u.pm = fm + ((wgid % nig) % gsz); u.pn = (wgid % nig) / gsz; return true;
    }
};
#ifndef FG_ALIGN
#define FG_ALIGN true
#endif
#ifndef FG_SP2
#define FG_SP2 true
#endif
template <class Epi, bool ALIGN_EPI = FG_ALIGN, bool SP2 = FG_SP2>
DEVI void gemm_phase(FG_LAS unsigned char* lds, const Gemm g, const StaticOrder& S, const Epi& E) {
    const int tid = threadIdx.x, wid = __builtin_amdgcn_readfirstlane(tid >> 6), lane = tid & 63, wr = wid >> 2, wc = wid & 3, fr = lane & 15, fq = lane >> 4;
    const int K = g.K, nt = K / BK;
    unsigned voffA[2], voffB[2];
#pragma unroll
    for (int i = 0; i < 2; ++i) { int R, C; stage_rc(tid * 16 + i * 8192, R, C); const int Rb = Epi::PERM ? ((R & ~31) + perm32(R & 31)) : R;
        voffA[i] = (unsigned)(R * g.lda + C) * 2u; voffB[i] = (unsigned)(Rb * g.ldb + C) * 2u; }
    const size_t kstep = (size_t)(BK * 2);
    const size_t hstepA = g.hstepA, hstepB = (size_t)HALF * g.ldb * 2;
    const unsigned ldsw = (unsigned)wid * 1024u;
    const int aoff = lds_byte(wr * 64 + fr, fq * 8), boff = lds_byte(wc * 32 + fr, fq * 8);
#define FG_SA(b, h) (((b) * 2 + (h)) * HTB)
#define FG_SB(b, h) ((4 + (b) * 2 + (h)) * HTB)
#define FG_STAGE(bufoff, gbase, voff) do { _Pragma("unroll") for (int _i = 0; _i < 2; ++_i) \
        __builtin_amdgcn_global_load_lds((const unsigned*)((const char*)(gbase) + (voff)[_i]), (FG_LAS unsigned*)(lds + (bufoff) + ldsw + _i * 8192), 16, 0, 0); } while (0)
#define FG_LDA(dst, b, h) do { _Pragma("unroll") for (int m = 0; m < 4; ++m) _Pragma("unroll") for (int k = 0; k < 2; ++k) dst[m][k] = *(const FG_LAS h16x8*)(lds + FG_SA(b, h) + aoff + m * 2048 + k * 1024); } while (0)
#define FG_LDB(dst, b, h) do { _Pragma("unroll") for (int n = 0; n < 2; ++n) _Pragma("unroll") for (int k = 0; k < 2; ++k) dst[n][k] = *(const FG_LAS h16x8*)(lds + FG_SB(b, h) + boff + n * 2048 + k * 1024); } while (0)
#define FG_CAT8(v) __builtin_shufflevector(__builtin_bit_cast(i32x4, (v)[0]), __builtin_bit_cast(i32x4, (v)[1]), 0, 1, 2, 3, 4, 5, 6, 7)
#define FG_MMA(ai, bj, At, Bt) do { __builtin_amdgcn_s_setprio(1); \
        if constexpr (Epi::FP8) { _Pragma("unroll") for (int m = 0; m < 4; ++m) _Pragma("unroll") for (int n = 0; n < 2; ++n) { \
            const i32x8 a8 = FG_CAT8(At[m]), b8 = FG_CAT8(Bt[n]); \
            asm volatile("v_mfma_scale_f32_16x16x128_f8f6f4 %0, %1, %2, %0, %3, %3 op_sel_hi:[0,0,0]" : "+v"(acc[ai][bj][m][n]) : "v"(b8), "v"(a8), "v"(sc8)); } } \
        else { _Pragma("unroll") for (int m = 0; m < 4; ++m) _Pragma("unroll") for (int n = 0; n < 2; ++n) _Pragma("unroll") for (int k = 0; k < 2; ++k) \
            acc[ai][bj][m][n] = __builtin_amdgcn_mfma_f32_16x16x32_f16(Bt[n][k], At[m][k], acc[ai][bj][m][n], 0, 0, 0); } \
        __builtin_amdgcn_s_setprio(0); } while (0)
#define FG_WAIT_V(n) asm volatile("s_waitcnt vmcnt(" #n ")" ::: "memory")
#define FG_WAIT_L(n) asm volatile("s_waitcnt lgkmcnt(" #n ")" ::: "memory")
#define FG_BAR __builtin_amdgcn_s_barrier()
#define FG_SCHED __builtin_amdgcn_sched_barrier(0)
    Unit cur, nxt; int ui = 0;
    if (!S.next(0, cur)) return;
    int sc8 = 0x7F7F7F7F; asm volatile("" : "+v"(sc8));
    f32x4 acc[2][2][4][2];
#pragma unroll
    for (int a = 0; a < 2; ++a)
#pragma unroll
        for (int b = 0; b < 2; ++b)
#pragma unroll
            for (int m = 0; m < 4; ++m)
#pragma unroll
                for (int n = 0; n < 2; ++n) acc[a][b][m][n] = (f32x4){0.f, 0.f, 0.f, 0.f};
    h16x8 At[4][2], B0[2][2], B1[2][2];
    const char* cA = g.a_tile(cur); const char* cB = g.b_tile(cur);
    if constexpr (SP2) {
        FG_STAGE(FG_SB(0, 0), cB, voffB); FG_STAGE(FG_SB(0, 1), cB + hstepB, voffB); FG_STAGE(FG_SA(0, 0), cA, voffA); FG_STAGE(FG_SA(0, 1), cA + hstepA, voffA);
        if (wr == 1) FG_BAR;
        FG_WAIT_V(2); FG_BAR;
        FG_STAGE(FG_SB(1, 0), cB + kstep, voffB); FG_STAGE(FG_SA(1, 0), cA + kstep, voffA); FG_STAGE(FG_SB(1, 1), cB + hstepB + kstep, voffB);
        FG_WAIT_V(6); FG_BAR;
    } else {
        FG_STAGE(FG_SB(0, 0), cB, voffB); FG_STAGE(FG_SA(0, 0), cA, voffA); FG_STAGE(FG_SB(0, 1), cB + hstepB, voffB); FG_STAGE(FG_SA(0, 1), cA + hstepA, voffA);
        if (wr == 1) FG_BAR;
        FG_WAIT_V(4); FG_BAR;
        FG_STAGE(FG_SB(1, 0), cB + kstep, voffB); FG_STAGE(FG_SA(1, 0), cA + kstep, voffA); FG_STAGE(FG_SB(1, 1), cB + hstepB + kstep, voffB);
        FG_WAIT_V(6); FG_BAR;
    }
    for (;;) {
        const bool has_next = S.next(ui + 1, nxt);
        const char* nA = has_next ? g.a_tile(nxt) : cA; const char* nB = has_next ? g.b_tile(nxt) : cB;
        for (int t = 0; t < nt; t += 2) {
            const bool last = (t == nt - 2);
            const char* a1 = cA + (size_t)(t + 1) * kstep;
            const char* a2 = last ? nA : cA + (size_t)(t + 2) * kstep; const char* b2 = last ? nB : cB + (size_t)(t + 2) * kstep;
            const char* a3 = a2 + kstep; const char* b3 = b2 + kstep;
            if constexpr (SP2) {
            FG_LDB(B0, 0, 0); FG_LDB(B1, 0, 1); FG_SCHED; FG_LDA(At, 0, 0); FG_STAGE(FG_SA(1, 1), a1 + hstepA, voffA);
            FG_WAIT_V(8); FG_WAIT_L(0); FG_BAR; FG_MMA(0, 0, At, B0); FG_MMA(0, 1, At, B1); FG_BAR; FG_SCHED;
            FG_LDA(At, 0, 1); FG_STAGE(FG_SB(0, 0), b2, voffB); FG_STAGE(FG_SB(0, 1), b2 + hstepB, voffB); FG_STAGE(FG_SA(0, 0), a2, voffA);
            FG_WAIT_V(8); FG_WAIT_L(0); FG_BAR; FG_MMA(1, 0, At, B0); FG_MMA(1, 1, At, B1); FG_BAR; FG_SCHED;
            FG_LDB(B0, 1, 0); FG_LDB(B1, 1, 1); FG_SCHED; FG_LDA(At, 1, 0); FG_STAGE(FG_SA(0, 1), a2 + hstepA, voffA);
            FG_WAIT_V(8); FG_WAIT_L(0); FG_BAR; FG_MMA(0, 0, At, B0); FG_MMA(0, 1, At, B1); FG_BAR; FG_SCHED;
            FG_LDA(At, 1, 1); FG_STAGE(FG_SB(1, 0), b3, voffB); FG_STAGE(FG_SB(1, 1), b3 + hstepB, voffB); FG_STAGE(FG_SA(1, 0), a3, voffA);
            FG_WAIT_V(8); FG_WAIT_L(0); FG_BAR; FG_MMA(1, 0, At, B0); FG_MMA(1, 1, At, B1); FG_BAR; FG_SCHED;
            } else {
            FG_LDB(B0, 0, 0); FG_SCHED; FG_LDA(At, 0, 0); FG_STAGE(FG_SA(1, 1), a1 + hstepA, voffA);
            FG_WAIT_L(8); FG_BAR; FG_WAIT_L(0); FG_MMA(0, 0, At, B0); FG_BAR; FG_SCHED;
            FG_LDB(B1, 0, 1); FG_STAGE(FG_SB(0, 0), b2, voffB);
            FG_BAR; FG_WAIT_L(0); FG_MMA(0, 1, At, B1); FG_BAR;
            FG_LDA(At, 0, 1); FG_STAGE(FG_SA(0, 0), a2, voffA);
            FG_BAR; FG_WAIT_L(0); FG_MMA(1, 0, At, B0); FG_BAR; FG_SCHED;
            FG_STAGE(FG_SB(0, 1), b2 + hstepB, voffB);
            FG_WAIT_V(6); FG_BAR; FG_MMA(1, 1, At, B1); FG_BAR;
            FG_LDB(B0, 1, 0); FG_SCHED; FG_LDA(At, 1, 0); FG_STAGE(FG_SA(0, 1), a2 + hstepA, voffA);
            FG_WAIT_L(8); FG_BAR; FG_WAIT_L(0); FG_MMA(0, 0, At, B0); FG_BAR; FG_SCHED;
            FG_LDB(B1, 1, 1); FG_STAGE(FG_SB(1, 0), b3, voffB);
            FG_BAR; FG_WAIT_L(0); FG_MMA(0, 1, At, B1); FG_BAR;
            FG_LDA(At, 1, 1); FG_STAGE(FG_SA(1, 0), a3, voffA);
            FG_BAR; FG_WAIT_L(0); FG_MMA(1, 0, At, B0); FG_BAR; FG_SCHED;
            FG_STAGE(FG_SB(1, 1), b3 + hstepB, voffB);
            FG_WAIT_V(6); FG_BAR; FG_MMA(1, 1, At, B1); FG_BAR;
            }
        }
        if constexpr (Epi::FP8) asm volatile("s_nop 15\n\ts_nop 15" ::: "memory");
        if constexpr (ALIGN_EPI) { if (wr == 0) FG_BAR; }
        E(acc, cur, wr, wc, fr, fq);
        if (!has_next) break;
#pragma unroll
        for (int a = 0; a < 2; ++a)
#pragma unroll
            for (int b = 0; b < 2; ++b)
#pragma unroll
                for (int m = 0; m < 4; ++m)
#pragma unroll
                    for (int n = 0; n < 2; ++n) acc[a][b][m][n] = (f32x4){0.f, 0.f, 0.f, 0.f};
        cur = nxt; cA = nA; cB = nB; ++ui;
        if constexpr (ALIGN_EPI) { if (wr == 1) FG_BAR; }
    }
    FG_WAIT_V(0);
    if constexpr (!ALIGN_EPI) { if (wr == 0) FG_BAR; }
    FG_BAR;
#undef FG_SA
#undef FG_SB
#undef FG_STAGE
#undef FG_LDA
#undef FG_LDB
#undef FG_MMA
#undef FG_CAT8
#undef FG_WAIT_V
#undef FG_WAIT_L
#undef FG_BAR
#undef FG_SCHED
}
}

constexpr size_t WS_WIN = 10 * MiB;
constexpr size_t WS_WOUT = 16 * MiB;
constexpr size_t WS_W13 = 18 * MiB;
constexpr size_t WS_W2 = 29 * MiB;
constexpr size_t WS_W2Q = 37 * MiB;
constexpr float U8_SCALE = 4.f, W2_SCALE = 512.f;
constexpr size_t WS_WC1 = 35 * MiB;
constexpr size_t WS_POSB = 9 * MiB;
constexpr size_t WS_HID = 104 * MiB;

DEVI int inproj_src(int nrow) {
    const int pn = nrow >> 8, tc = nrow & 255;
    if (pn < 5) { const int gi = 4 * pn + ((tc & 127) >> 5), d = 32 * (tc >> 7) + (tc & 31); return 64 * gi + d; }
    if (pn < 7) return 1304 + 256 * (pn - 5) + tc;
    if (pn < 11) return (tc < 128 ? 1816 : 2328) + 128 * (pn - 7) + (tc & 127);
    return tc < 24 ? 1280 + tc : -1;
}
template <class SRC, bool F8 = false>
DEVI void transpose_item(const SRC& src, int K, h16* WT, float* scr, int item, int nblk, int lane, unsigned char* WT8 = nullptr) {
    const int kb = item / nblk, nb = item % nblk, k0 = 64 * kb, n0 = 32 * nb;
    float tv[32];
#pragma unroll
    for (int i = 0; i < 32; ++i) tv[i] = src(k0 + 2 * i + (lane >> 5), n0 + (lane & 31));
#pragma unroll
    for (int i = 0; i < 32; ++i) scr[(2 * i + (lane >> 5)) * 33 + (lane & 31)] = tv[i];
    asm volatile("s_waitcnt lgkmcnt(0)" ::: "memory");
    const int c = lane & 7;
#pragma unroll
    for (int j = 0; j < 4; ++j) { const int n = (lane >> 3) + 8 * j; const float* s = scr + (8 * c) * 33 + n;
        if constexpr (F8) {
            float v[8];
#pragma unroll
            for (int q = 0; q < 8; ++q) v[q] = __builtin_amdgcn_fmed3f(s[q * 33] * W2_SCALE, -448.f, 448.f);
            int p0 = 0, p1 = 0;
            p0 = __builtin_amdgcn_cvt_pk_fp8_f32(v[0], v[1], p0, false); p0 = __builtin_amdgcn_cvt_pk_fp8_f32(v[2], v[3], p0, true);
            p1 = __builtin_amdgcn_cvt_pk_fp8_f32(v[4], v[5], p1, false); p1 = __builtin_amdgcn_cvt_pk_fp8_f32(v[6], v[7], p1, true);
            *(int2*)(WT8 + (size_t)(n0 + n) * K + k0 + 8 * c) = make_int2(p0, p1);
        }
        h16x8 o;
#pragma unroll
        for (int q = 0; q < 8; ++q) o[q] = (h16)s[q * 33];
        *(h16x8*)(WT + (size_t)(n0 + n) * K + k0 + 8 * c) = o; }
    asm volatile("s_waitcnt lgkmcnt(0)" ::: "memory");
}
struct SrcWin { const float* W; DEVI float operator()(int k, int n) const { const int s = inproj_src(n); return s < 0 ? 0.f : W[(size_t)k * NPROJ + s]; } };
struct SrcWout { const float *W, *ga, *gc; DEVI float operator()(int k, int n) const { return W[(size_t)k * 1024 + n] * (k < 512 ? ga[k] : gc[k - 512]); } };
struct SrcW13 { const float *W1, *W3; DEVI float operator()(int k, int n) const { const int pn = n >> 8, tc = n & 255; return tc < 128 ? W1[(size_t)k * DFF + 128 * pn + tc] : W3[(size_t)k * DFF + 128 * pn + tc - 128]; } };
struct SrcW2 { const float* W; DEVI float operator()(int k, int n) const { return W[(size_t)k * 1024 + n]; } };
struct SrcWc1 { const float *Wk, *Wv; DEVI float operator()(int k, int n) const { return n < 256 ? Wk[(size_t)k * 256 + n] : Wv[(size_t)k * 256 + n - 256]; } };
template <bool F8>
struct EF_ffn2 {
    static constexpr bool PERM = true;
    static constexpr bool FP8 = F8;
    const Params* P;
    int odd;
    DEVI void operator()(const fg::f32x4 (&acc)[2][2][4][2], const fg::Unit& u, int wr, int wc, int fr_, int fq_) const {
        int t_ = threadIdx.x; asm volatile("" : "+v"(t_));
        const int fr = t_ & 15, fq = (t_ >> 4) & 3;
        const Params& p = *P;
        const float* mod = (const float*)(p.ws + WS_MOD);
        const h16* X1 = (const h16*)(p.ws + WS_A2);
        const int b = 2 * (u.pm >> 3) + odd, row0 = b * 2048 + (u.pm & 7) * 256;
        constexpr float osc = F8 ? 1.f / (U8_SCALE * W2_SCALE) : 1.f;
#pragma unroll
        for (int bj = 0; bj < 2; ++bj) {
            const int col = u.pn * 256 + 128 * bj + 32 * wc + 8 * fq;
            h16x8 xv[2][4];
#pragma unroll
            for (int ai = 0; ai < 2; ++ai)
#pragma unroll
                for (int m = 0; m < 4; ++m) xv[ai][m] = *(const h16x8*)(X1 + (size_t)(row0 + 128 * ai + 64 * wr + 16 * m + fr) * 1024 + col);
            fg::f32x4 g2[2], rg[2];
#pragma unroll
            for (int n = 0; n < 2; ++n) {
                g2[n] = *(const fg::f32x4*)(mod + b * 6144 + 5120 + col + 4 * n) * osc;
                rg[n] = *(const fg::f32x4*)(p.norm2_gain + col + 4 * n) * (*(const fg::f32x4*)(mod + b * 6144 + 4096 + col + 4 * n) + 1.f);
#pragma unroll
                for (int i = 0; i < 4; ++i) rg[n][i] = rg[n][i] != 0.f ? __builtin_amdgcn_rcpf(rg[n][i]) : 0.f;
            }
#pragma unroll
            for (int ai = 0; ai < 2; ++ai)
#pragma unroll
                for (int m = 0; m < 4; ++m) {
                    float* op = p.out + (size_t)(row0 + 128 * ai + 64 * wr + 16 * m + fr) * 1024 + col;
#pragma unroll
                    for (int n = 0; n < 2; ++n) {
                        fg::f32x4 o;
#pragma unroll
                        for (int i = 0; i < 4; ++i) o[i] = (float)xv[ai][m][4 * n + i] * rg[n][i] + g2[n][i] * acc[ai][bj][m][n][i];
                        *(fg::f32x4*)(op + 4 * n) = o;
                    }
                }
        }
    }
};
DEVI void ph_ffn2_fast(const Params& P, unsigned char* lds_raw) {
    fg::StaticOrder S; S.init(MTOK / 2, 1024, gridDim.x, blockIdx.x);
    {
        fg::Gemm g{(const h16*)(P.ws + WS_U), nullptr, (const h16*)(P.ws + WS_W2Q), MTOK / 2, 1024, DFF / 2, DFF / 2, (size_t)128 * DFF, DFF / 2};
        EF_ffn2<true> E{&P, 0};
        fg::gemm_phase<EF_ffn2<true>>((FG_LAS unsigned char*)lds_raw, g, S, E);
    }
    {
        fg::Gemm g{(const h16*)(P.ws + WS_U8), nullptr, (const h16*)(P.ws + WS_W2Q), MTOK / 2, 1024, DFF / 2, DFF / 2, (size_t)128 * DFF, DFF / 2};
        EF_ffn2<true> E{&P, 1};
        fg::gemm_phase<EF_ffn2<true>>((FG_LAS unsigned char*)lds_raw, g, S, E);
    }
}

struct EF_ffn1 {
    static constexpr bool PERM = true;
    static constexpr bool FP8 = false;
    const Params* P;
    FG_LAS unsigned char* lds;
    static constexpr int L_RSTD = 131072, L_BIAS = 131072 + 1024, L_FLAG = 131072 + 1024 + 11264;
    DEVI void operator()(const fg::f32x4 (&acc)[2][2][4][2], const fg::Unit& u, int wr, int wc, int fr, int fq) const {
        const Params& p = *P;
        const int b = (u.pm * 256) >> 11, col = 128 * u.pn + 32 * wc + 8 * fq;
        if (*(volatile FG_LAS int*)(lds + L_FLAG) != u.pm) {
            __syncthreads();
            const int t = threadIdx.x;
            if (t < 256) {
                const float* sq = (const float*)(p.ws + WS_SSQ2) + (size_t)(u.pm * 256 + t) * 16;
                const fg::f32x4 s0 = *(const fg::f32x4*)sq, s1 = *(const fg::f32x4*)(sq + 4), s2 = *(const fg::f32x4*)(sq + 8), s3 = *(const fg::f32x4*)(sq + 12);
                const float g0 = (s0[0] + s0[1]) + (s0[2] + s0[3]), g1 = (s1[0] + s1[1]) + (s1[2] + s1[3]), g2 = (s2[0] + s2[1]) + (s2[2] + s2[3]), g3 = (s3[0] + s3[1]) + (s3[2] + s3[3]);
                ((FG_LAS float*)(lds + L_RSTD))[t] = rsqrtf(((g0 + g1) + (g2 + g3)) * (1.f / 1024.f) + EPSF);
            }
            const float* bias13 = (const float*)(p.ws + WS_B13P) + b * 5632;
            for (int c = t; c < 704; c += 512) {
                fg::f32x4 pa[4], pb[4];
#pragma unroll
                for (int ks = 0; ks < 4; ++ks) { pa[ks] = *(const fg::f32x4*)(bias13 + (size_t)ks * 16 * 5632 + 8 * c); pb[ks] = *(const fg::f32x4*)(bias13 + (size_t)ks * 16 * 5632 + 8 * c + 4); }
                const fg::f32x4 v0 = (pa[0] + pa[1]) + (pa[2] + pa[3]), v1 = (pb[0] + pb[1]) + (pb[2] + pb[3]);
                h16x8 o;
#pragma unroll
                for (int i = 0; i < 4; ++i) { o[i] = (h16)v0[i]; o[4 + i] = (h16)v1[i]; }
                *(FG_LAS h16x8*)(lds + L_BIAS + 16 * c) = o;
            }
            if (t == 0) *(volatile FG_LAS int*)(lds + L_FLAG) = u.pm;
            __syncthreads();
        }
        float rstd[2][4];
#pragma unroll
        for (int ai = 0; ai < 2; ++ai)
#pragma unroll
            for (int m = 0; m < 4; ++m) rstd[ai][m] = ((const FG_LAS float*)(lds + L_RSTD))[128 * ai + 64 * wr + 16 * m + fr];
        const h16x8 b1h = *(const FG_LAS h16x8*)(lds + L_BIAS + 2 * col), b3h = *(const FG_LAS h16x8*)(lds + L_BIAS + 2 * (2816 + col));
#pragma unroll
        for (int ai = 0; ai < 2; ++ai)
#pragma unroll
            for (int m = 0; m < 4; ++m) {
                const int row = u.pm * 256 + 128 * ai + 64 * wr + 16 * m + fr;
                float o[8];
#pragma unroll
                for (int n = 0; n < 2; ++n)
#pragma unroll
                    for (int i = 0; i < 4; ++i) {
                        const float a = rstd[ai][m] * acc[ai][0][m][n][i] + (float)b1h[4 * n + i];
                        const float c = rstd[ai][m] * acc[ai][1][m][n][i] + (float)b3h[4 * n + i];
                        o[4 * n + i] = silu_fast(a) * c;
                    }
                const size_t crow = (size_t)(b >> 1) * 2048 + (row & 2047);
                if (true) {
                    int p0 = 0, p1 = 0;
#pragma unroll
                    for (int i = 0; i < 8; ++i) o[i] = __builtin_amdgcn_fmed3f(o[i] * U8_SCALE, -448.f, 448.f);
                    p0 = __builtin_amdgcn_cvt_pk_fp8_f32(o[0], o[1], p0, false); p0 = __builtin_amdgcn_cvt_pk_fp8_f32(o[2], o[3], p0, true);
                    p1 = __builtin_amdgcn_cvt_pk_fp8_f32(o[4], o[5], p1, false); p1 = __builtin_amdgcn_cvt_pk_fp8_f32(o[6], o[7], p1, true);
                    *(int2*)(p.ws + ((b & 1) ? WS_U8 : WS_U) + crow * DFF + col) = make_int2(p0, p1);
                } else {
                    h16x8 oh;
#pragma unroll
                    for (int i = 0; i < 8; ++i) oh[i] = (h16)o[i];
                    *(h16x8*)((h16*)(p.ws + WS_U) + crow * DFF + col) = oh;
                }
            }
    }
};
DEVI void ph_ffn1_fast(const Params& P, unsigned char* lds_raw) {
    fg::Gemm g{(const h16*)(P.ws + WS_A2), nullptr, (const h16*)(P.ws + WS_W13), MTOK, 5632, 1024, 1024, (size_t)128 * 1024 * 2, 1024};
    fg::StaticOrder S; S.init(MTOK, 5632, gridDim.x, blockIdx.x);
    EF_ffn1 E{&P, (FG_LAS unsigned char*)lds_raw};
    if (threadIdx.x == 0) *(volatile FG_LAS int*)((FG_LAS unsigned char*)lds_raw + EF_ffn1::L_FLAG) = -1;
    __syncthreads();
    fg::gemm_phase<EF_ffn1>((FG_LAS unsigned char*)lds_raw, g, S, E);
}

struct EF_outproj {
    static constexpr bool PERM = true;
    static constexpr bool FP8 = false;
    const Params* P;
    DEVI void operator()(const fg::f32x4 (&acc)[2][2][4][2], const fg::Unit& u, int wr, int wc, int fr, int fq) const {
        const Params& p = *P;
        const float* mod = (const float*)(p.ws + WS_MOD);
        h16* A2 = (h16*)(p.ws + WS_A2);
        float* SSQ = (float*)(p.ws + WS_SSQ2);
        const int b = (u.pm * 256) >> 11;
        float ss[2][4];
#pragma unroll
        for (int ai = 0; ai < 2; ++ai)
#pragma unroll
            for (int m = 0; m < 4; ++m) ss[ai][m] = 0.f;
#pragma unroll
        for (int bj = 0; bj < 2; ++bj) {
            const int col = u.pn * 256 + 128 * bj + 32 * wc + 8 * fq;
            fg::f32x4 g1[2], gs[2];
#pragma unroll
            for (int n = 0; n < 2; ++n) {
                g1[n] = *(const fg::f32x4*)(mod + b * 6144 + 2048 + col + 4 * n);
                const fg::f32x4 s2 = *(const fg::f32x4*)(mod + b * 6144 + 4096 + col + 4 * n), n2 = *(const fg::f32x4*)(p.norm2_gain + col + 4 * n);
                gs[n] = n2 * (s2 + 1.f);
            }
#pragma unroll
            for (int ai = 0; ai < 2; ++ai) {
                fg::f32x4 xv[4][2];
#pragma unroll
                for (int m = 0; m < 4; ++m) { const float* xp = p.x + (size_t)(u.pm * 256 + 128 * ai + 64 * wr + 16 * m + fr) * 1024 + col; xv[m][0] = *(const fg::f32x4*)xp; xv[m][1] = *(const fg::f32x4*)(xp + 4); }
#pragma unroll
                for (int m = 0; m < 4; ++m) {
                    const int row = u.pm * 256 + 128 * ai + 64 * wr + 16 * m + fr;
                    h16x8 ah;
#pragma unroll
                    for (int n = 0; n < 2; ++n) {
                        const fg::f32x4 x1 = xv[m][n] + g1[n] * acc[ai][bj][m][n];
                        const fg::f32x4 a = x1 * gs[n];
#pragma unroll
                        for (int i = 0; i < 4; ++i) ah[4 * n + i] = (h16)a[i];
                        ss[ai][m] += (x1[0] * x1[0] + x1[1] * x1[1]) + (x1[2] * x1[2] + x1[3] * x1[3]);
                    }
                    *(h16x8*)(A2 + (size_t)row * 1024 + col) = ah;
                }
            }
        }
#pragma unroll
        for (int ai = 0; ai < 2; ++ai)
#pragma unroll
            for (int m = 0; m < 4; ++m) {
                float s = ss[ai][m];
                s += __shfl_xor(s, 16); s += __shfl_xor(s, 32);
                if (fq == 0) SSQ[(size_t)(u.pm * 256 + 128 * ai + 64 * wr + 16 * m + fr) * 16 + u.pn * 4 + wc] = s;
            }
    }
};
DEVI void ph_outproj_fast(const Params& P, unsigned char* lds_raw) {
    fg::Gemm g{(const h16*)(P.ws + WS_Y), nullptr, (const h16*)(P.ws + WS_WOUT), MTOK, 1024, 1024, 1024, (size_t)128 * 1024 * 2, 1024};
    fg::StaticOrder S; S.init(MTOK, 1024, gridDim.x, blockIdx.x);
    EF_outproj E{&P};
    fg::gemm_phase<EF_outproj>((FG_LAS unsigned char*)lds_raw, g, S, E);
}

struct EF_inproj {
    static constexpr bool PERM = true;
    static constexpr bool FP8 = false;
    const Params* P;
    FG_LAS unsigned char* lds;
    static constexpr int L_GAIN = 131072;
    DEVI void operator()(const fg::f32x4 (&acc)[2][2][4][2], const fg::Unit& u, int wr, int wc, int fr, int fq) const {
        const Params& p = *P;
        const int pn = u.pn;
        if (pn < 5) {
            const int gi = 4 * pn + wc;
            const int kind = gi < 8 ? 0 : 1 + ((gi - 8) >> 1), g = gi & 1;
            const bool normed = (kind == 0 || kind == 3 || kind == 5);
            const float qsc = kind == 0 ? 0.125f * 1.4426950408889634f : 1.f;
            const FG_LAS float* gn = (const FG_LAS float*)(lds + L_GAIN) + (kind == 0 ? 0 : kind == 3 ? 64 : 128);
            fg::f32x4 gv[2][2];
#pragma unroll
            for (int bj = 0; bj < 2; ++bj)
#pragma unroll
                for (int n = 0; n < 2; ++n) gv[bj][n] = normed ? *(const FG_LAS fg::f32x4*)(gn + 32 * bj + 8 * fq + 4 * n) : (fg::f32x4){1.f, 1.f, 1.f, 1.f};
            h16* base = (h16*)(p.ws + (kind == 0 ? WS_QH : kind == 1 ? WS_KCH : kind == 2 ? WS_VC : kind == 3 ? WS_KS : kind == 4 ? WS_VS : kind == 5 ? WS_KW : WS_VW));
#pragma unroll
            for (int ai = 0; ai < 2; ++ai)
#pragma unroll
                for (int m = 0; m < 4; ++m) {
                    const int row = u.pm * 256 + 128 * ai + 64 * wr + 16 * m + fr;
                    float ss = 0.f;
#pragma unroll
                    for (int bj = 0; bj < 2; ++bj)
#pragma unroll
                        for (int n = 0; n < 2; ++n) { const fg::f32x4 v = acc[ai][bj][m][n]; ss += (v[0] * v[0] + v[1] * v[1]) + (v[2] * v[2] + v[3] * v[3]); }
                    ss += __shfl_xor(ss, 16); ss += __shfl_xor(ss, 32);
                    const float rstd = normed ? rsqrtf(ss * (1.f / 64.f) + EPSF) : 1.f;
                    h16* dst = kind == 0 ? base + (size_t)row * 512 + gi * 64 : base + ((size_t)((row >> 11) * 2 + g) * 2048 + (row & 2047)) * 64;
#pragma unroll
                    for (int bj = 0; bj < 2; ++bj) {
                        h16x8 o;
                        if (kind == 4 || kind == 6) {
                            bf16x8_t ob;
#pragma unroll
                            for (int n = 0; n < 2; ++n)
#pragma unroll
                                for (int i = 0; i < 4; ++i) ob[4 * n + i] = (__bf16)acc[ai][bj][m][n][i];
                            o = __builtin_bit_cast(h16x8, ob);
                        } else {
#pragma unroll
                            for (int n = 0; n < 2; ++n)
#pragma unroll
                                for (int i = 0; i < 4; ++i) o[4 * n + i] = (h16)(acc[ai][bj][m][n][i] * (rstd * qsc) * gv[bj][n][i]);
                        }
                        *(h16x8*)(dst + 32 * bj + 8 * fq) = o;
                    }
                }
        } else if (pn < 7) {
            h16* BCX = (h16*)(p.ws + WS_BCX);
#pragma unroll
            for (int ai = 0; ai < 2; ++ai)
#pragma unroll
                for (int m = 0; m < 4; ++m) {
                    const int row = u.pm * 256 + 128 * ai + 64 * wr + 16 * m + fr;
#pragma unroll
                    for (int bj = 0; bj < 2; ++bj) {
                        h16x8 o;
#pragma unroll
                        for (int n = 0; n < 2; ++n)
#pragma unroll
                            for (int i = 0; i < 4; ++i) o[4 * n + i] = (h16)acc[ai][bj][m][n][i];
                        *(h16x8*)(BCX + (size_t)row * 1024 + 256 * (pn - 5) + 128 * bj + 32 * wc + 8 * fq) = o;
                    }
                }
        } else if (pn < 11) {
            h16* BCX = (h16*)(p.ws + WS_BCX);
#pragma unroll
            for (int ai = 0; ai < 2; ++ai)
#pragma unroll
                for (int m = 0; m < 4; ++m) {
                    const int row = u.pm * 256 + 128 * ai + 64 * wr + 16 * m + fr;
                    h16x8 o;
#pragma unroll
                    for (int n = 0; n < 2; ++n)
#pragma unroll
                        for (int i = 0; i < 4; ++i) o[4 * n + i] = (h16)(acc[ai][0][m][n][i] * acc[ai][1][m][n][i]);
                    *(h16x8*)(BCX + (size_t)row * 1024 + 512 + 128 * (pn - 7) + 32 * wc + 8 * fq) = o;
                }
        } else {
            if (wc == 0 && fq < 3) {
                float* GA = (float*)(p.ws + WS_GATES);
#pragma unroll
                for (int ai = 0; ai < 2; ++ai)
#pragma unroll
                    for (int m = 0; m < 4; ++m) {
                        const int row = u.pm * 256 + 128 * ai + 64 * wr + 16 * m + fr;
#pragma unroll
                        for (int n = 0; n < 2; ++n) *(fg::f32x4*)(GA + (size_t)row * 24 + 8 * fq + 4 * n) = acc[ai][0][m][n];
                    }
            }
        }
    }
};
DEVI void ph_inproj_fast(const Params& P, unsigned char* lds_raw) {
    fg::Gemm g{(const h16*)(P.ws + WS_A1H), nullptr, (const h16*)(P.ws + WS_WIN), MTOK, 3072, 1024, 1024, (size_t)128 * 1024 * 2, 1024};
    fg::StaticOrder S; S.init(MTOK, 3072, gridDim.x, blockIdx.x);
    EF_inproj E{&P, (FG_LAS unsigned char*)lds_raw};
    if (threadIdx.x < 192) { const int k = threadIdx.x >> 6, d = threadIdx.x & 63; ((FG_LAS float*)((FG_LAS unsigned char*)lds_raw + EF_inproj::L_GAIN))[threadIdx.x] = (k == 0 ? P.q_gain : k == 1 ? P.k_sel_gain : P.k_win_gain)[d]; }
    __syncthreads();
    fg::gemm_phase<EF_inproj>((FG_LAS unsigned char*)lds_raw, g, S, E);
}

constexpr size_t WS_SH2H = 140 * MiB;
constexpr size_t WS_HIDP = 104 * MiB;
struct EF_compress {
    static constexpr bool PERM = true;
    static constexpr bool FP8 = false;
    const Params* P;
    DEVI void operator()(const fg::f32x4 (&acc)[2][2][4][2], const fg::Unit& u, int wr, int wc, int fr, int fq) const {
        const Params& p = *P;
        h16* HID = (h16*)(p.ws + WS_HIDP) + (size_t)(u.pn >> 1) * 4096 * 512 + 256 * (u.pn & 1);
#pragma unroll
        for (int bj = 0; bj < 2; ++bj) {
            const int col = 128 * bj + 32 * wc + 8 * fq;
#pragma unroll
            for (int ai = 0; ai < 2; ++ai)
#pragma unroll
                for (int m = 0; m < 4; ++m) {
                    const int row = u.pm * 256 + 128 * ai + 64 * wr + 16 * m + fr;
                    h16x8 o;
#pragma unroll
                    for (int n = 0; n < 2; ++n)
#pragma unroll
                        for (int i = 0; i < 4; ++i) o[4 * n + i] = (h16)acc[ai][bj][m][n][i];
                    *(h16x8*)(HID + (size_t)row * 512 + col) = o;
                }
        }
    }
};
DEVI void ph_compress_fast(const Params& P, unsigned char* lds_raw) {
    fg::Gemm g{(const h16*)(P.ws + WS_KCH), (const h16*)(P.ws + WS_VC), (const h16*)(P.ws + WS_WC1), 4096, 2048, 512, 1024, (size_t)2048 * 64 * 2, 2048};
    fg::StaticOrder S; S.init(4096, 2048, gridDim.x, blockIdx.x);
    EF_compress E{&P};
    fg::gemm_phase<EF_compress>((FG_LAS unsigned char*)lds_raw, g, S, E);
}
struct EF_bias13 {
    static constexpr bool PERM = true;
    static constexpr bool FP8 = false;
    const Params* P;
    DEVI void operator()(const fg::f32x4 (&acc)[2][2][4][2], const fg::Unit& u, int wr, int wc, int fr, int fq) const {
        if (wr != 0) return;
        const int pn = u.pn >> 2, ks = u.pn & 3;
        float* bias13 = (float*)(P->ws + WS_B13P) + (size_t)(ks * 16 + fr) * 5632 + 128 * pn + 32 * wc + 8 * fq;
#pragma unroll
        for (int n = 0; n < 2; ++n) { *(fg::f32x4*)(bias13 + 4 * n) = acc[0][0][0][n]; *(fg::f32x4*)(bias13 + 2816 + 4 * n) = acc[0][1][0][n]; }
    }
};
DEVI void ph_bias13_gemm(const Params& P, unsigned char* lds_raw) {
    fg::Gemm g{(const h16*)(P.ws + WS_SH2H), nullptr, (const h16*)(P.ws + WS_W13), 256, 5632 * 4, 256, 1024, (size_t)128 * 1024 * 2, 1024, 4};
    const bool wide = gridDim.x >= 216;
    const int G = wide ? 88 : (int)gridDim.x, c = wide ? (int)blockIdx.x - 128 : (int)blockIdx.x;
    if (c < 0 || c >= G) return;
    fg::StaticOrder S; S.init(256, 5632 * 4, G, c);
    EF_bias13 E{&P};
    fg::gemm_phase<EF_bias13>((FG_LAS unsigned char*)lds_raw, g, S, E);
}
constexpr size_t WS_MODP = 144 * MiB;
constexpr size_t WS_POSBP = 9 * MiB + 64 * 1024;
DEVI void fma16(float (&acc)[16], const float* s, float w) {
    const float4 s0 = *(const float4*)(s), s1 = *(const float4*)(s + 4), s2 = *(const float4*)(s + 8), s3 = *(const float4*)(s + 12);
    acc[0] += s0.x * w; acc[1] += s0.y * w; acc[2] += s0.z * w; acc[3] += s0.w * w; acc[4] += s1.x * w; acc[5] += s1.y * w; acc[6] += s1.z * w; acc[7] += s1.w * w;
    acc[8] += s2.x * w; acc[9] += s2.y * w; acc[10] += s2.z * w; acc[11] += s2.w * w; acc[12] += s3.x * w; acc[13] += s3.y * w; acc[14] += s3.z * w; acc[15] += s3.w * w;
}
DEVI void ph_prep2(const Params& P, float* lds) {
    const int tid = threadIdx.x, blk = blockIdx.x;
    const int lane = tid & 63, wv = tid >> 6;
    if (gridDim.x == 256 ? blk < 192 : true) {
        for (int task = blk; task < 192; task += (gridDim.x == 256 ? 192 : gridDim.x)) {
            const int ks = task & 15, jc = task >> 4;
            float* sT = lds;
            __syncthreads();
            for (int i = tid; i < 1024; i += 512) { const int kk = i >> 4, b = i & 15; sT[i] = siluf(P.c[b * 1024 + ks * 64 + kk]); }
            __syncthreads();
            const int j = jc * 512 + tid;
            float acc[16];
#pragma unroll
            for (int b = 0; b < 16; ++b) acc[b] = 0.f;
            const float* w = P.w_ada + (size_t)(ks * 64) * 6144 + j;
#pragma unroll 1
            for (int k0 = 0; k0 < 64; k0 += 32) {
                float wv32[32];
#pragma unroll
                for (int kk = 0; kk < 32; ++kk) wv32[kk] = w[(size_t)(k0 + kk) * 6144];
#pragma unroll
                for (int kk = 0; kk < 32; ++kk) { fma16(acc, sT + (k0 + kk) * 16, wv32[kk]); if ((kk & 3) == 3) __builtin_amdgcn_sched_barrier(0); }
            }
            float* modp = (float*)(P.ws + WS_MODP);
#pragma unroll
            for (int b = 0; b < 16; ++b) modp[(size_t)(ks * 16 + b) * 6144 + j] = acc[b];
        }
        __syncthreads();
    }
    if (gridDim.x == 256 ? blk >= 192 : true) {
        for (int ks = (gridDim.x == 256 ? blk - 192 : blk); ks < 64; ks += (gridDim.x == 256 ? 64 : gridDim.x)) {
            const int which = tid >> 8, j = tid & 255;
            const float* w1 = (which ? P.w_cv1 : P.w_ck1) + (size_t)(ks * 32) * 256 + j;
            const float* pos = (which ? P.cmp_pos_v : P.cmp_pos_k) + ks * 32;
            float wv32[32], acc = 0.f;
#pragma unroll
            for (int kk = 0; kk < 32; ++kk) wv32[kk] = w1[(size_t)kk * 256];
#pragma unroll
            for (int kk = 0; kk < 32; ++kk) acc += pos[kk] * wv32[kk];
            ((float*)(P.ws + WS_POSBP))[ks * 512 + tid] = acc;
        }
    }
    float* scr = lds + wv * 4096;
    constexpr int I_IN = 16 * 96, I_OUT = 16 * 32, I_13 = 16 * 176, I_2 = 44 * 32, I_C = 32 * 16, NIT = I_IN + I_OUT + I_13 + I_2 + I_C;
    int it0, its, ite;
    if (gridDim.x == 256) { if (blk < 192) { it0 = blk * 8 + wv; its = 1536; ite = 4608; } else { it0 = 4608 + (blk - 192) * 8 + wv; its = 512; ite = NIT; } }
    else { it0 = blk * 8 + wv; its = gridDim.x * 8; ite = NIT; }
    for (int it = it0; it < ite; it += its) {
        int r = it;
        if (r < I_IN) { transpose_item(SrcWin{P.w_in}, 1024, (h16*)(P.ws + WS_WIN), scr, r, 96, lane); continue; } r -= I_IN;
        if (r < I_OUT) { transpose_item(SrcWout{P.w_out, P.attn_out_gain, P.conv_out_gain}, 1024, (h16*)(P.ws + WS_WOUT), scr, r, 32, lane); continue; } r -= I_OUT;
        if (r < I_13) { transpose_item(SrcW13{P.w_ff1, P.w_ff3}, 1024, (h16*)(P.ws + WS_W13), scr, r, 176, lane); continue; } r -= I_13;
        if (r < I_2) { transpose_item<SrcW2, true>(SrcW2{P.w_ff2}, DFF, (h16*)(P.ws + WS_W2), scr, r, 32, lane, P.ws + WS_W2Q); continue; } r -= I_2;
        transpose_item(SrcWc1{P.w_ck1, P.w_cv1}, 2048, (h16*)(P.ws + WS_WC1), scr, r, 16, lane);
    }
}
DEVI void ph_norm1_2(const Params& P, float* lds) {
    const int tid = threadIdx.x, lane = tid & 63, wv = tid >> 6, blk = blockIdx.x;
    const float* modp = (const float*)(P.ws + WS_MODP);
    float* mod = (float*)(P.ws + WS_MOD);
    h16* A1H = (h16*)(P.ws + WS_A1H);
    for (int rg = blk; rg < 256; rg += gridDim.x) {
        const int b = rg >> 4, sl = rg & 15;
        float* ms = lds;
        {
            float v4[4];
#pragma unroll
            for (int q = 0; q < 4; ++q) v4[q] = P.b_ada[tid + 512 * q];
#pragma unroll
            for (int ks = 0; ks < 16; ++ks)
#pragma unroll
                for (int q = 0; q < 4; ++q) v4[q] += modp[(size_t)(ks * 16 + b) * 6144 + tid + 512 * q];
#pragma unroll
            for (int q = 0; q < 4; ++q) ms[tid + 512 * q] = v4[q];
        }
        if (tid < 384) { const int j = sl * 384 + tid; float v = P.b_ada[j];
#pragma unroll
            for (int ks = 0; ks < 16; ++ks) v += modp[(size_t)(ks * 16 + b) * 6144 + j];
            mod[b * 6144 + j] = v;
            if (j >= 3072 && j < 4096) ((h16*)(P.ws + WS_SH2H))[b * 1024 + j - 3072] = (h16)v; }
        __syncthreads();
        for (int r = wv * 16; r < wv * 16 + 16; r += 8) {
            float4 v[8][4];
#pragma unroll
            for (int rr = 0; rr < 8; ++rr) { const float* xr = P.x + (size_t)(rg * 128 + r + rr) * 1024;
#pragma unroll
                for (int j = 0; j < 4; ++j) { const fg::f32x4 t = __builtin_nontemporal_load((const fg::f32x4*)(xr + 256 * j + 4 * lane)); v[rr][j] = make_float4(t[0], t[1], t[2], t[3]); } }
#pragma unroll
            for (int rr = 0; rr < 8; ++rr) {
                const int row = rg * 128 + r + rr;
                float s = 0.f;
#pragma unroll
                for (int j = 0; j < 4; ++j) s += v[rr][j].x * v[rr][j].x + v[rr][j].y * v[rr][j].y + v[rr][j].z * v[rr][j].z + v[rr][j].w * v[rr][j].w;
                const float rstd = rsqrtf(wsum(s) * (1.f / 1024.f) + EPSF);
#pragma unroll
                for (int j = 0; j < 4; ++j) {
                    const int k = 256 * j + 4 * lane;
                    const float4 g = *(const float4*)(P.norm1_gain + k);
                    const float4 sh = *(const float4*)(ms + k);
                    const float4 sc = *(const float4*)(ms + 1024 + k);
                    h16x4 hi;
                    hi[0] = (h16)(v[rr][j].x * rstd * g.x * (1.f + sc.x) + sh.x);
                    hi[1] = (h16)(v[rr][j].y * rstd * g.y * (1.f + sc.y) + sh.y);
                    hi[2] = (h16)(v[rr][j].z * rstd * g.z * (1.f + sc.z) + sh.z);
                    hi[3] = (h16)(v[rr][j].w * rstd * g.w * (1.f + sc.w) + sh.w);
                    *(h16x4*)(A1H + (size_t)row * 1024 + k) = hi;
                }
            }
        }
        __syncthreads();
    }
    if (blk == 88) {
        const float* pp = (const float*)(P.ws + WS_POSBP);
        float v = 0.f;
#pragma unroll
        for (int ks = 0; ks < 64; ++ks) v += pp[ks * 512 + tid];
        ((float*)(P.ws + WS_POSB))[tid] = v;
    }
}
constexpr int CW_CONVQ2 = 128;
constexpr unsigned CONV_P3 = 0;
constexpr int CW_CONVQ = 64;
DEVI void ph_conv2(const Params& P, float* lds, int tk, unsigned c0, unsigned c1) {
    const int lane = threadIdx.x & 63, wv = threadIdx.x >> 6;
    const h16* BCX = (const h16*)(P.ws + WS_BCX);
    h16* Y = (h16*)(P.ws + WS_Y);
    unsigned* ticket = (unsigned*)(P.ws + WS_CTL) + tk;
    volatile unsigned* slot = (volatile unsigned*)lds;
    const int c = lane * 8;
    float cw[3][8];
#pragma unroll
    for (int k = 0; k < 3; ++k)
#pragma unroll
        for (int i = 0; i < 8; ++i) cw[k][i] = P.conv_w[k * 512 + c + i];
    for (;;) {
        __syncthreads();
        if (threadIdx.x == 0) slot[0] = __hip_atomic_fetch_add(ticket, 1u, __ATOMIC_RELAXED, __HIP_MEMORY_SCOPE_AGENT);
        __syncthreads();
        const unsigned chunk = c0 + slot[0];
        if (chunk >= c1) break;
        const int rowb = chunk * 64 + wv * 8, tb = rowb & 2047;
        const h16* rb = BCX + (size_t)rowb * 1024;
        float um1[8], um2[8];
        {
            h16x8 ua = {}, ub = {};
            if (tb >= 1) ua = *(const h16x8*)(rb - 1024 + 512 + c);
            if (tb >= 2) ub = *(const h16x8*)(rb - 2048 + 512 + c);
#pragma unroll
            for (int i = 0; i < 8; ++i) { um1[i] = (float)ua[i]; um2[i] = (float)ub[i]; }
        }
#pragma unroll
        for (int half = 0; half < 2; ++half) {
            h16x8 bgv[4], uv[4];
#pragma unroll
            for (int j = 0; j < 4; ++j) { const h16* r2 = rb + (size_t)(half * 4 + j) * 1024; bgv[j] = *(const h16x8*)(r2 + c); uv[j] = *(const h16x8*)(r2 + 512 + c); }
#pragma unroll
            for (int j = 0; j < 4; ++j) {
                float y[8], ssq = 0.f;
#pragma unroll
                for (int i = 0; i < 8; ++i) {
                    const float u0 = (float)uv[j][i];
                    y[i] = (float)bgv[j][i] * (um2[i] * cw[0][i] + um1[i] * cw[1][i] + u0 * cw[2][i]);
                    um2[i] = um1[i]; um1[i] = u0;
                    ssq += y[i] * y[i];
                }
                const float rstd = rsqrtf(wsum(ssq) * (1.f / 512.f) + EPSF);
                h16x8 o;
#pragma unroll
                for (int i = 0; i < 8; ++i) o[i] = (h16)(y[i] * rstd);
                *(h16x8*)(Y + (size_t)(rowb + half * 4 + j) * 1024 + 512 + c) = o;
            }
        }
    }
}
DEVI void ph_compress2b(const Params& P, unsigned char* lds_raw) {
    FG_LAS unsigned char* lds = (FG_LAS unsigned char*)lds_raw;
    const int tid = threadIdx.x, lane = tid & 63, wv = __builtin_amdgcn_readfirstlane(tid >> 6), fr = lane & 15, fq = lane >> 4;
    const int which = blockIdx.x & 1, nbw = (gridDim.x + 1 - which) >> 1, bw = blockIdx.x >> 1;
    const float* w2 = which ? P.w_cv2 : P.w_ck2;
    constexpr int WP = 264;
    FG_LAS h16* W2T = (FG_LAS h16*)lds;
    FG_LAS float* PS = (FG_LAS float*)(lds + 64 * WP * 2);
    for (int i = tid; i < 256 * 16; i += 512) {
        const int k = i >> 4, c4 = (i & 15) * 4;
        const float4 v = *(const float4*)(w2 + k * 64 + c4);
        W2T[(c4 + 0) * WP + k] = (h16)v.x; W2T[(c4 + 1) * WP + k] = (h16)v.y; W2T[(c4 + 2) * WP + k] = (h16)v.z; W2T[(c4 + 3) * WP + k] = (h16)v.w;
    }
    __syncthreads();
    const h16* HID = (const h16*)(P.ws + WS_HIDP);
    const float* posb = (const float*)(P.ws + WS_POSB) + 256 * which;
    h16* dst = (h16*)(P.ws + (which ? WS_VCC : WS_KCNH));
    const int rt = wv >> 2, ct = wv & 3;
    const float gain = P.k_cmp_gain[16 * ct + fr];
#pragma unroll 1
    for (int rb = bw * 32; rb < 4096; rb += nbw * 32) {
        const int row = rb + 16 * rt + fr;
        fg::f32x4 acc = {0.f, 0.f, 0.f, 0.f};
#pragma unroll
        for (int half = 0; half < 2; ++half) {
            h16x8 hv[4][4];
#pragma unroll
            for (int s4 = 0; s4 < 4; ++s4)
#pragma unroll
                for (int ks = 0; ks < 4; ++ks) hv[s4][ks] = *(const h16x8*)(HID + (size_t)ks * 4096 * 512 + (size_t)row * 512 + 256 * which + 32 * (4 * half + s4) + 8 * fq);
#pragma unroll
            for (int s4 = 0; s4 < 4; ++s4) {
                const int k0 = 32 * (4 * half + s4) + 8 * fq;
                const float4 p0 = *(const float4*)(posb + k0), p1 = *(const float4*)(posb + k0 + 4);
                float pre[8] = {p0.x, p0.y, p0.z, p0.w, p1.x, p1.y, p1.z, p1.w};
#pragma unroll
                for (int ks = 0; ks < 4; ++ks)
#pragma unroll
                    for (int j = 0; j < 8; ++j) pre[j] += (float)hv[s4][ks][j];
                h16x8 a8;
#pragma unroll
                for (int j = 0; j < 8; ++j) a8[j] = (h16)silu_fast(pre[j]);
                const h16x8 b8 = *(const FG_LAS h16x8*)(W2T + (16 * ct + fr) * WP + k0);
                acc = __builtin_amdgcn_mfma_f32_16x16x32_f16(a8, b8, acc, 0, 0, 0);
            }
        }
#pragma unroll
        for (int i = 0; i < 4; ++i) if (((rb + 16 * rt + 4 * fq + i) & 127) == 127) acc[i] = 0.f;
        if (which == 0) {
            float ss[4];
#pragma unroll
            for (int i = 0; i < 4; ++i) { float v = acc[i] * acc[i]; v += __shfl_xor(v, 1); v += __shfl_xor(v, 2); v += __shfl_xor(v, 4); v += __shfl_xor(v, 8); ss[i] = v; }
            if (fr == 0) {
#pragma unroll
                for (int i = 0; i < 4; ++i) PS[(rt * 16 + 4 * fq + i) * 4 + ct] = ss[i];
            }
            __syncthreads();
#pragma unroll
            for (int i = 0; i < 4; ++i) {
                const fg::f32x4 t = *(const FG_LAS fg::f32x4*)(PS + (rt * 16 + 4 * fq + i) * 4);
                const float tot = (t[0] + t[1]) + (t[2] + t[3]);
                acc[i] = acc[i] * rsqrtf(tot * (1.f / 64.f) + EPSF) * gain;
            }
            __syncthreads();
        }
#pragma unroll
        for (int i = 0; i < 4; ++i) {
            const size_t o = (size_t)(rb + 16 * rt + 4 * fq + i) * 64 + 16 * ct + fr;
            if (which) { const __bf16 ob = (__bf16)acc[i]; dst[o] = __builtin_bit_cast(h16, ob); } else dst[o] = (h16)acc[i];
        }
    }
}

namespace fa {
#define FA_LAS __attribute__((address_space(3)))
typedef float f32x16 __attribute__((ext_vector_type(16)));
typedef short s16x4 __attribute__((ext_vector_type(4)));
typedef short s16x8 __attribute__((ext_vector_type(8)));
constexpr float LOG2E = 1.4426950408889634f, NEGBIG = -30000.f, THR = 8.f;
constexpr int STAGE_B = 32768, L_BIAS = 65536, L_OT = 69632  , L_SLAB = 69632,
              L_SELM = 135168, L_SSQ = 135424, L_CB = 141568, OST_PITCH = 1040;

struct TileSrc { const h16 *k0, *k1, *v0, *v1; };
struct WaveCtx { int hi; int koff[4]; int voff; int dk, dv; FA_LAS const float* brow; };
DEVI void tile_dma(const TileSrc& S, int key0, FA_LAS unsigned char* st, const WaveCtx& W, int wv) {
    const size_t ko = (size_t)key0 * 64 + W.dk, vo = (size_t)key0 * 64 + W.dv;
    __builtin_amdgcn_global_load_lds((const unsigned*)(S.k0 + ko), (FA_LAS unsigned*)(st + wv * 1024), 16, 0, 0);
    __builtin_amdgcn_global_load_lds((const unsigned*)(S.k1 + ko), (FA_LAS unsigned*)(st + 8192 + wv * 1024), 16, 0, 0);
    __builtin_amdgcn_global_load_lds((const unsigned*)(S.v0 + vo), (FA_LAS unsigned*)(st + 16384 + wv * 1024), 16, 0, 0);
    __builtin_amdgcn_global_load_lds((const unsigned*)(S.v1 + vo), (FA_LAS unsigned*)(st + 24576 + wv * 1024), 16, 0, 0);
}
DEVI float max3f(float a, float b, float c) { float r; asm("v_max3_f32 %0, %1, %2, %3" : "=v"(r) : "v"(a), "v"(b), "v"(c)); return r; }

template <bool LOOKUP, bool EMASK, int RELMUL, int PSB>
DEVI void tile_step(FA_LAS const unsigned char* Kt, FA_LAS const unsigned char* Vt, const WaveCtx& W, const h16x8 (&qf)[4], f32x16 (&O)[2], float& mhat, float& lsum,
                    float cinit, int relb, int klo, int khi, f32x16& pA, f32x16& pB) {
    f32x16 p0, p1;
    {
        h16x8 kf[8];
#pragma unroll
        for (int s = 0; s < 4; ++s) { kf[2 * s] = *(FA_LAS const h16x8*)(Kt + W.koff[s]); kf[2 * s + 1] = *(FA_LAS const h16x8*)(Kt + 4096 + W.koff[s]); }
#pragma unroll
        for (int r = 0; r < 16; ++r) { p0[r] = cinit; p1[r] = cinit; }
        __builtin_amdgcn_sched_barrier(0);
        __builtin_amdgcn_s_setprio(1);
        p0 = __builtin_amdgcn_mfma_f32_32x32x16_f16(kf[0], qf[0], p0, 0, 0, 0);
        p1 = __builtin_amdgcn_mfma_f32_32x32x16_f16(kf[1], qf[0], p1, 0, 0, 0);
#pragma unroll
        for (int s = 1; s < 4; ++s) {
            p0 = __builtin_amdgcn_mfma_f32_32x32x16_f16(kf[2 * s], qf[s], p0, 0, 0, 0);
            p1 = __builtin_amdgcn_mfma_f32_32x32x16_f16(kf[2 * s + 1], qf[s], p1, 0, 0, 0);
        }
        __builtin_amdgcn_s_setprio(0);
    }
    const unsigned vb = (unsigned)(uintptr_t)Vt + (unsigned)W.voff;
    s16x4 vlo[8], vhi[8];
#pragma unroll
    for (int i = 0; i < 8; ++i) {
        asm volatile("ds_read_b64_tr_b16 %0, %1 offset:%c2" : "=&v"(vlo[i]) : "v"(vb), "i"((i >> 2) * 4096 + ((i >> 1) & 1) * 2048 + (i & 1) * 256) : "memory");
        asm volatile("ds_read_b64_tr_b16 %0, %1 offset:%c2" : "=&v"(vhi[i]) : "v"(vb), "i"((i >> 2) * 4096 + ((i >> 1) & 1) * 2048 + (i & 1) * 256 + 1024) : "memory");
    }
    if (LOOKUP) {
        const int relh = relb - RELMUL * 4 * W.hi;
#pragma unroll
        for (int r = 0; r < 16; ++r) {
            const int kc = (r & 3) + 8 * (r >> 2);
            int i0 = relh - RELMUL * kc;
            i0 = i0 < 0 ? 0 : (i0 > 127 ? 127 : i0);
            p0[r] += W.brow[i0];
        }
        __builtin_amdgcn_sched_barrier(0);
#pragma unroll
        for (int r = 0; r < 16; ++r) {
            const int kc = (r & 3) + 8 * (r >> 2);
            int i1 = relh - RELMUL * (kc + 32);
            i1 = i1 < 0 ? 0 : (i1 > 127 ? 127 : i1);
            p1[r] += W.brow[i1];
        }
    }
    if (EMASK) {
        const int kl = klo - 4 * W.hi, kh = khi - 4 * W.hi;
#pragma unroll
        for (int r = 0; r < 16; ++r) {
            const int kc = (r & 3) + 8 * (r >> 2);
            p0[r] = (kc >= kl && kc <= kh) ? p0[r] : NEGBIG;
            p1[r] = (kc + 32 >= kl && kc + 32 <= kh) ? p1[r] : NEGBIG;
        }
    }
    float sacc = 0.f, sacc1 = 0.f;
#pragma unroll
    for (int r = 0; r < 16; ++r) { p0[r] = __builtin_amdgcn_exp2f(p0[r]); p1[r] = __builtin_amdgcn_exp2f(p1[r]); sacc += p0[r]; asm("" : "+v"(sacc)); sacc1 += p1[r]; asm("" : "+v"(sacc1)); }
    lsum += sacc + sacc1;
    if (PSB >= 0) {
#pragma unroll
        for (int g4 = 0; g4 < 4; ++g4) {
            pA[PSB + g4] += 2.f * (p0[4 * g4] + p0[4 * g4 + 1] + p0[4 * g4 + 2]) + p0[4 * g4 + 3]; pB[PSB + g4] += p0[4 * g4 + 3];
            pA[PSB + 4 + g4] += 2.f * (p1[4 * g4] + p1[4 * g4 + 1] + p1[4 * g4 + 2]) + p1[4 * g4 + 3]; pB[PSB + 4 + g4] += p1[4 * g4 + 3];
        }
    }
    bf16x8_t pk[4];
#pragma unroll
    for (int kk = 0; kk < 4; ++kk)
#pragma unroll
        for (int j = 0; j < 8; ++j) pk[kk][j] = (__bf16)((kk >> 1) ? p1[8 * (kk & 1) + j] : p0[8 * (kk & 1) + j]);
    asm volatile("s_waitcnt lgkmcnt(0)" : "+v"(vlo[0]), "+v"(vhi[0]), "+v"(vlo[1]), "+v"(vhi[1]), "+v"(vlo[2]), "+v"(vhi[2]), "+v"(vlo[3]), "+v"(vhi[3]),
                 "+v"(vlo[4]), "+v"(vhi[4]), "+v"(vlo[5]), "+v"(vhi[5]), "+v"(vlo[6]), "+v"(vhi[6]), "+v"(vlo[7]), "+v"(vhi[7]) :: "memory");
    __builtin_amdgcn_sched_barrier(0);
    __builtin_amdgcn_s_setprio(1);
#pragma unroll
    for (int i = 0; i < 8; ++i) {
        const s16x8 v8 = {vlo[i][0], vlo[i][1], vlo[i][2], vlo[i][3], vhi[i][0], vhi[i][1], vhi[i][2], vhi[i][3]};
        O[i & 1] = __builtin_amdgcn_mfma_f32_32x32x16_bf16(__builtin_bit_cast(bf16x8_t, v8), pk[i >> 1], O[i & 1], 0, 0, 0);
    }
    __builtin_amdgcn_s_setprio(0);
}

DEVI unsigned wave_or(unsigned v) {
#pragma unroll
    for (int o = 1; o < 64; o <<= 1) v |= (unsigned)__shfl_xor((int)v, o);
    return v;
}

template <int MODE>
DEVI void branch_loop(unsigned tmask, const TileSrc& S, FA_LAS unsigned char* lds, const WaveCtx& W, const h16x8 (&qf)[4], f32x16 (&O)[2], float& mhat, float& lsum,
                      int g, int wv, int tq, int bt, int jlo, unsigned lmask, unsigned gunion) {
    f32x16 dA, dB;
    int jb = __builtin_ctz(tmask); tmask &= tmask - 1;
    tile_dma(S, 64 * jb, lds, W, wv);
    __syncthreads();
    int cur = 0;
    const float b31 = W.brow[127];
#pragma unroll 1
    for (;;) {
        const int nj = tmask ? __builtin_ctz(tmask) : -1;
        if (nj >= 0) { tmask &= tmask - 1; tile_dma(S, 64 * nj, lds + (cur ^ 1) * STAGE_B, W, wv); }
        FA_LAS const unsigned char* st = lds + cur * STAGE_B;
        FA_LAS const unsigned char* Kt = st + g * 8192;
        FA_LAS const unsigned char* Vt = st + 16384 + g * 8192;
        const bool lookup = (jb + 2 >= bt);
        const int relb = tq - 64 * jb;
        if (MODE == 1) {
            if ((gunion >> jb) & 1u) {
                const bool sel = (lmask >> jb) & 1u;
                if (jb == bt) tile_step<true, true, 1, -1>(Kt, Vt, W, qf, O, mhat, lsum, sel ? -mhat : NEGBIG, relb, -1000, relb, dA, dB);
                else if (lookup) tile_step<true, false, 1, -1>(Kt, Vt, W, qf, O, mhat, lsum, sel ? -mhat : NEGBIG, relb, 0, 0, dA, dB);
                else tile_step<false, false, 1, -1>(Kt, Vt, W, qf, O, mhat, lsum, sel ? b31 - mhat : NEGBIG, relb, 0, 0, dA, dB);
            }
        } else {
            const bool emask = (jb == bt) || (jb == jlo);
            if (lookup) {
                if (emask) tile_step<true, true, 1, -1>(Kt, Vt, W, qf, O, mhat, lsum, -mhat, relb, relb - 511, relb, dA, dB);
                else tile_step<true, false, 1, -1>(Kt, Vt, W, qf, O, mhat, lsum, -mhat, relb, 0, 0, dA, dB);
            } else {
                if (emask) tile_step<false, true, 1, -1>(Kt, Vt, W, qf, O, mhat, lsum, b31 - mhat, relb, relb - 511, relb, dA, dB);
                else tile_step<false, false, 1, -1>(Kt, Vt, W, qf, O, mhat, lsum, b31 - mhat, relb, 0, 0, dA, dB);
            }
        }
        __syncthreads();
        if (nj < 0) break;
        jb = nj; cur ^= 1;
    }
}

DEVI void attn_unit(const Params& P, FA_LAS unsigned char* lds, int b, int qt) {
    const int tid = threadIdx.x, lane = tid & 63, wv = __builtin_amdgcn_readfirstlane(tid >> 6), hi = lane >> 5, q = lane & 31, g = wv >> 2;
    const int q0 = 32 * qt, bt = q0 >> 6, tq = q0 + q, row0 = b * 2048 + q0;
    WaveCtx W; W.hi = hi;
    { const int x = (q >> 1) & 7;
#pragma unroll
      for (int s = 0; s < 4; ++s) W.koff[s] = q * 128 + (((2 * s + hi) ^ x) * 16); }
    W.voff = hi * 512 + ((lane >> 4) & 1) * 128 + ((lane & 15) >> 2) * 32 + (lane & 3) * 8;
    W.dk = (8 * wv + (lane >> 3)) * 64 + (((lane & 7) ^ ((4 * wv + (lane >> 4)) & 7)) * 8);
    W.dv = (8 * wv + 4 * (lane >> 5) + ((lane & 7) >> 1)) * 64 + ((lane >> 3) & 3) * 16 + (lane & 1) * 8;
    W.brow = (FA_LAS const float*)(lds + L_BIAS) + wv * 128;
    FA_LAS float* OtL = (FA_LAS float*)(lds + L_OT) + wv * 2048 + lane;
    const h16* QH = (const h16*)(P.ws + WS_QH);
    h16x8 qf[4];
#pragma unroll
    for (int s = 0; s < 4; ++s) qf[s] = *(const h16x8*)(QH + (size_t)(row0 + q) * 512 + wv * 64 + 16 * s + 8 * hi);
    FA_LAS float* gts = (FA_LAS float*)(lds + L_SSQ + 1024) + wv * 96;
    if (hi == 0) { const float* gl = (const float*)(P.ws + WS_GATES) + (size_t)(row0 + q) * 24 + wv * 3; gts[q] = sigm_fast(gl[0]); gts[32 + q] = sigm_fast(gl[1]); gts[64 + q] = sigm_fast(gl[2]); }
    unsigned lmask = (2u << bt) - 1u, gunion = lmask, uall = lmask;
    {
        const size_t cb = (size_t)b * 2 * 128 * 64;
        TileSrc S{(const h16*)(P.ws + WS_KCNH) + cb, (const h16*)(P.ws + WS_KCNH) + cb + 128 * 64, (const h16*)(P.ws + WS_VCC) + cb, (const h16*)(P.ws + WS_VCC) + cb + 128 * 64};
        const bool two = (q0 >> 4) >= 64;
        tile_dma(S, 0, lds, W, wv);
        if (two) tile_dma(S, 64, lds + STAGE_B, W, wv);
        __syncthreads();
        f32x16 O[2], pA, pB;
#pragma unroll
        for (int r = 0; r < 16; ++r) { O[0][r] = 0.f; O[1][r] = 0.f; pA[r] = 0.f; pB[r] = 0.f; }
        float mhat = ((FA_LAS const float*)(lds + L_CB))[wv], lsum = 0.f;
        const int nq = tq >= 31 ? (tq - 31) >> 4 : -1;
        tile_step<true, true, 16, 0>(lds + g * 8192, lds + 16384 + g * 8192, W, qf, O, mhat, lsum, -mhat, tq - 31, -1000, nq, pA, pB);
        if (two) tile_step<true, true, 16, 8>(lds + STAGE_B + g * 8192, lds + STAGE_B + 16384 + g * 8192, W, qf, O, mhat, lsum, -mhat, tq - 31 - 1024, -1000, nq - 64, pA, pB);
        const float lt = lsum + __shfl_xor(lsum, 32);
        const float inv = lt > 0.f ? 1.f / lt : 0.f;
        const float sc = gts[q] * inv;
#pragma unroll
        for (int r = 0; r < 16; ++r) { O[0][r] *= sc; O[1][r] *= sc; }
        if (bt >= 16) {
            FA_LAS float* slab = (FA_LAS float*)(lds + L_SLAB) + (wv * 32 + q) * 32;
#pragma unroll
            for (int i = 0; i < 16; ++i) {
                const float a = pA[i] * inv, bv = pB[i] * inv;
                const float rc = __shfl_xor(bv, 32);
                float rp = 0.f;
                if (i > 0) rp = __shfl_xor(pB[i - 1] * inv, 32);
                slab[2 * i + hi] = a + (hi ? rc : rp);
            }
        }
        __syncthreads();
        if (bt >= 16) {
            FA_LAS const float* slabs = (FA_LAS const float*)(lds + L_SLAB);
            FA_LAS unsigned* selm = (FA_LAS unsigned*)(lds + L_SELM);
            int lane2 = threadIdx.x & 63; asm volatile("" : "+v"(lane2));
            const int j = lane2 & 31;
#pragma unroll 1
            for (int it = 0; it < 4; ++it) {
                const int rr = 8 * wv + 2 * it + (lane2 >> 5), gg = rr >> 5, qq = rr & 31;
                float sc2 = 0.f;
#pragma unroll
                for (int hh = 0; hh < 4; ++hh) sc2 += slabs[((gg * 4 + hh) * 32 + qq) * 32 + j];
                FA_LAS float* srow = (FA_LAS float*)(lds + 139520) + wv * 64 + (lane2 & 32);
                srow[j] = sc2;
                int rank = 0;
#pragma unroll
                for (int i4 = 0; i4 < 8; ++i4) {
                    const fg::f32x4 s4 = *(FA_LAS const fg::f32x4*)(srow + 4 * i4);
                    const float sv[4] = {s4[0], s4[1], s4[2], s4[3]};
#pragma unroll
                    for (int e = 0; e < 4; ++e) { const int i = 4 * i4 + e; rank += (i >= 1 && i <= bt - 2 && (sv[e] > sc2 || (sv[e] == sc2 && i < j))) ? 1 : 0; }
                }
                const bool forced = (j == 0 || j == bt || j == bt - 1), cand = (j >= 1 && j <= bt - 2);
                const bool sel = forced || (cand && rank < 13);
                const unsigned long long m64 = __ballot(sel);
                if (lane2 == 0) { selm[8 * wv + 2 * it] = (unsigned)m64; selm[8 * wv + 2 * it + 1] = (unsigned)(m64 >> 32); }
            }
            __syncthreads();
            lmask = selm[g * 32 + (lane2 & 31)];
            gunion = wave_or(lmask);
            uall = wave_or(selm[lane2]);
            gunion = __builtin_amdgcn_readfirstlane(gunion); uall = __builtin_amdgcn_readfirstlane(uall);
        }
#pragma unroll
        for (int r = 0; r < 16; ++r) { OtL[r * 64] = O[0][r]; OtL[(16 + r) * 64] = O[1][r]; }
    }
    {
        const size_t kb = (size_t)b * 2 * 2048 * 64;
        TileSrc S{(const h16*)(P.ws + WS_KS) + kb, (const h16*)(P.ws + WS_KS) + kb + 2048 * 64, (const h16*)(P.ws + WS_VS) + kb, (const h16*)(P.ws + WS_VS) + kb + 2048 * 64};
        f32x16 O[2];
#pragma unroll
        for (int r = 0; r < 16; ++r) { O[0][r] = 0.f; O[1][r] = 0.f; }
        float mhat = ((FA_LAS const float*)(lds + L_CB))[8 + wv], lsum = 0.f;
        branch_loop<1>(uall, S, lds, W, qf, O, mhat, lsum, g, wv, tq, bt, 0, lmask, gunion);
        const float lt = lsum + __shfl_xor(lsum, 32);
        const float sc = gts[32 + q] / lt;
#pragma unroll
        for (int r = 0; r < 16; ++r) { OtL[r * 64] += sc * O[0][r]; OtL[(16 + r) * 64] += sc * O[1][r]; }
    }
    {
        const size_t kb = (size_t)b * 2 * 2048 * 64;
        TileSrc S{(const h16*)(P.ws + WS_KW) + kb, (const h16*)(P.ws + WS_KW) + kb + 2048 * 64, (const h16*)(P.ws + WS_VW) + kb, (const h16*)(P.ws + WS_VW) + kb + 2048 * 64};
        f32x16 O[2];
#pragma unroll
        for (int r = 0; r < 16; ++r) { O[0][r] = 0.f; O[1][r] = 0.f; }
        float mhat = ((FA_LAS const float*)(lds + L_CB))[16 + wv], lsum = 0.f;
        const int jlo = q0 >= 511 ? (q0 - 511) >> 6 : 0;
        const unsigned wmask = ((2u << bt) - 1u) & ~((1u << jlo) - 1u);
        branch_loop<2>(wmask, S, lds, W, qf, O, mhat, lsum, g, wv, tq, bt, q0 >= 511 ? jlo : -1, 0u, 0u);
        const float lt = lsum + __shfl_xor(lsum, 32);
        const float sc = gts[64 + q] / lt;
        float ss = 0.f;
#pragma unroll
        for (int r = 0; r < 16; ++r) { O[0][r] = OtL[r * 64] + sc * O[0][r]; O[1][r] = OtL[(16 + r) * 64] + sc * O[1][r]; ss += O[0][r] * O[0][r] + O[1][r] * O[1][r]; }
        ss += __shfl_xor(ss, 32);
        int tid2 = threadIdx.x; asm volatile("" : "+v"(tid2));
        const int q2 = tid2 & 31, hi2 = (tid2 >> 5) & 1;
        FA_LAS float* ssq = (FA_LAS float*)(lds + L_SSQ);
        if (hi2 == 0) ssq[wv * 32 + q2] = ss;
        __syncthreads();
        float tot = 0.f;
#pragma unroll
        for (int w = 0; w < 8; ++w) tot += ssq[w * 32 + q2];
        const float rstd = rsqrtf(tot * (1.f / 512.f) + EPSF);
#pragma unroll
        for (int db = 0; db < 2; ++db)
#pragma unroll
            for (int g4 = 0; g4 < 4; ++g4) {
                h16x4 o;
#pragma unroll
                for (int i = 0; i < 4; ++i) o[i] = (h16)(O[db][4 * g4 + i] * rstd);
                *(FA_LAS h16x4*)(lds + q2 * OST_PITCH + (wv * 64 + 32 * db + 8 * g4 + 4 * hi2) * 2) = o;
            }
        __syncthreads();
        h16* Y = (h16*)(P.ws + WS_Y);
#pragma unroll
        for (int i = 0; i < 4; ++i) {
            const int cid = tid2 + 512 * i, rw = cid >> 6, cc = cid & 63;
            const h16x8 v = *(FA_LAS const h16x8*)(lds + rw * OST_PITCH + cc * 16);
            *(h16x8*)(Y + (size_t)(row0 + rw) * 1024 + cc * 8) = v;
        }
        __syncthreads();
    }
}

DEVI void attn_phase(const Params& P, unsigned char* lds_raw) {
    FA_LAS unsigned char* lds = (FA_LAS unsigned char*)lds_raw;
    FA_LAS float* bias = (FA_LAS float*)(lds + L_BIAS);
    for (int i = threadIdx.x; i < 8 * 128; i += 512) { const int h = i >> 7, n = i & 127; bias[i] = P.rel_bias[t5_bucket(n) * 8 + h] * LOG2E; }
    if (threadIdx.x < 24) {
        const int br = threadIdx.x >> 3, h = threadIdx.x & 7;
        const float* kg = br == 0 ? P.k_cmp_gain : br == 1 ? P.k_sel_gain : P.k_win_gain;
        float gq = 0.f, gk = 0.f, tb = 0.f;
        for (int d = 0; d < 64; ++d) { gq = fmaxf(gq, fabsf(P.q_gain[d])); gk = fmaxf(gk, fabsf(kg[d])); }
        for (int n = 0; n < 32; ++n) tb = fmaxf(tb, fabsf(P.rel_bias[n * 8 + h]));
        ((FA_LAS float*)(lds + L_CB))[threadIdx.x] = LOG2E * (8.f * gq * gk + tb) + 0.5f;
    }
    __syncthreads();
    if (gridDim.x == 256) {
        const int x = blockIdx.x & 7, m = blockIdx.x >> 3;
#pragma unroll 1
        for (int i = 0; i < 4; ++i) attn_unit(P, lds, 2 * x + (i >> 1), (i & 1) ? m : 63 - m);
    } else {
#pragma unroll 1
        for (int u = blockIdx.x; u < 1024; u += gridDim.x) attn_unit(P, lds, u >> 6, u & 63);
    }
}
}

#define LAS __attribute__((address_space(3)))
#define XB_TMO      128
#define XB_XCNT(j)  (256  + 64 * (j))
#define XB_XSUB(j)  (1280 + 64 * (j))
#define XB_XGEN(j)  (2304 + 64 * (j))
#define XB_TOP      3328
#define XB_TOPGEN   3392
#define XCD_BAR_WORDS 3456
#define XB_SPIN_CAP (1u << 22)
__device__ __forceinline__ unsigned xb_ld(unsigned* p)              { return __hip_atomic_load(p, __ATOMIC_RELAXED, __HIP_MEMORY_SCOPE_AGENT); }
__device__ __forceinline__ unsigned xb_add(unsigned* p, unsigned v) { return __hip_atomic_fetch_add(p, v, __ATOMIC_RELAXED, __HIP_MEMORY_SCOPE_AGENT); }
__device__ __forceinline__ unsigned xb_xcc_id() { return (unsigned)__builtin_amdgcn_s_getreg((3 << 11) | 20) & 0xFu; }
#define XB_SPIN(cond, bar) do { unsigned _sp = 0; while (cond) { __builtin_amdgcn_s_sleep(1); \
    if ((++_sp & 255u) == 0u) { if (xb_ld(&(bar)[XB_TMO])) break; if (_sp > XB_SPIN_CAP) { atomicAdd(&(bar)[XB_TMO], 1u); break; } } } } while (0)
struct XcdBarrier { unsigned* bar; unsigned x; volatile LAS unsigned* st; };
__device__ __forceinline__ XcdBarrier xcd_barrier_post(unsigned* bar, volatile LAS unsigned* st) {
    XcdBarrier b; b.bar = bar; b.x = xb_xcc_id(); b.st = st;
    if (threadIdx.x == 0) (void)xb_add(&bar[XB_XCNT(b.x)], 1u);
    return b;
}
__device__ __forceinline__ void xcd_barrier_complete(unsigned* bar, unsigned x, unsigned& nloc, unsigned& nx) {
    const unsigned G = gridDim.x * gridDim.y * gridDim.z;
    unsigned sum, cnt, mine, sp = 0u;
    for (;;) {
        sum = 0u; cnt = 0u; mine = 0u;
#pragma unroll
        for (unsigned j = 0; j < 16; ++j) { const unsigned c = xb_ld(&bar[XB_XCNT(j)]); sum += c; cnt += (c > 0u) ? 1u : 0u; mine = (j == x) ? c : mine; }
        if (sum == G) break;
        __builtin_amdgcn_s_sleep(1);
        if ((++sp & 255u) == 0u) { if (xb_ld(&bar[XB_TMO])) break; if (sp > XB_SPIN_CAP) { atomicAdd(&bar[XB_TMO], 1u); break; } }
    }
    nloc = mine > 0u ? mine : 1u; nx = cnt > 0u ? cnt : 1u;
}
__device__ __forceinline__ void xcd_barrier(const XcdBarrier& b) {
    asm volatile("s_waitcnt vmcnt(0)" ::: "memory");
    __syncthreads();
    if (threadIdx.x == 0) {
        unsigned* bar = b.bar;
        __builtin_amdgcn_s_waitcnt(0);
        unsigned nloc = b.st[0], nx = b.st[1];
        if (nloc == 0u) { xcd_barrier_complete(bar, b.x, nloc, nx); b.st[0] = nloc; b.st[1] = nx; }
        const unsigned old = xb_add(&bar[XB_XSUB(b.x)], 1u);
        const unsigned gen = old / nloc;
        if (old + 1u == (gen + 1u) * nloc) {
            __builtin_amdgcn_fence(__ATOMIC_RELEASE, "agent");
            asm volatile("s_waitcnt vmcnt(0)" ::: "memory");
            const unsigned og = xb_add(&bar[XB_TOP], 1u);
            const unsigned tg = og / nx;
            if (og + 1u == (tg + 1u) * nx) xb_add(&bar[XB_TOPGEN], 1u);
            else XB_SPIN(xb_ld(&bar[XB_TOPGEN]) == tg, bar);
            __builtin_amdgcn_fence(__ATOMIC_ACQUIRE, "agent");
            xb_add(&bar[XB_XGEN(b.x)], 1u);
            asm volatile("s_waitcnt vmcnt(0)" ::: "memory");
        } else {
            XB_SPIN(xb_ld(&bar[XB_XGEN(b.x)]) == gen, bar);
            __builtin_amdgcn_fence(__ATOMIC_ACQUIRE, "agent");
            asm volatile("s_waitcnt vmcnt(0)" ::: "memory");
        }
    }
    __syncthreads();
}

constexpr int CW_GRP4 = 1024;
constexpr size_t WS_XCCTAB = 512 * 1024;
__device__ __forceinline__ void grp4_sync(unsigned* cnt, bool same_xcd, unsigned* tmo) {
    asm volatile("s_waitcnt vmcnt(0)" ::: "memory");
    __syncthreads();
    if (threadIdx.x == 0) {
        if (!same_xcd) { __builtin_amdgcn_fence(__ATOMIC_RELEASE, "agent"); asm volatile("s_waitcnt vmcnt(0)" ::: "memory"); }
        xb_add(cnt, 1u);
        XB_SPIN(xb_ld(cnt) < 4u, tmo);
        __builtin_amdgcn_fence(__ATOMIC_ACQUIRE, "agent");
        asm volatile("s_waitcnt vmcnt(0)" ::: "memory");
    }
    __syncthreads();
}
constexpr int LDS_BYTES = 147456;
constexpr int MISC_OFF = 147456 - 256;
constexpr size_t CTL_ZERO_BYTES = 64 * 1024;
constexpr int CW_BAR = 4096;
struct Args { Params P; int ph_lo, ph_hi, li, pad; };
__global__ void __launch_bounds__(512, 2) mega_fwd(Args a) {
    extern __shared__ __attribute__((aligned(16))) unsigned char lds_raw[];
    float* lds = (float*)lds_raw;
    const Params& P = a.P;
    volatile LAS unsigned* MISC = (volatile LAS unsigned*)((LAS unsigned char*)lds_raw + MISC_OFF);
    if (threadIdx.x < 32) MISC[threadIdx.x] = 0u;
    __syncthreads();
    XcdBarrier bar = xcd_barrier_post((unsigned*)(P.ws + WS_CTL) + CW_BAR + a.li * XCD_BAR_WORDS, MISC + 8);
    if (threadIdx.x == 0) ((unsigned*)(P.ws + WS_XCCTAB))[blockIdx.x] = bar.x;
    const int lo = a.ph_lo, hi = a.ph_hi;
#define IN(k) (lo <= (k) && (k) < hi)
#define SEAM(k) do { if (IN(k) && IN((k) + 1)) xcd_barrier(bar); } while (0)
#ifdef ONLY_ATTN
    fa::attn_phase(P, lds_raw); return;
#endif
    if (IN(0)) ph_prep2(P, lds);
    SEAM(0);
#ifdef PROBE_BARS
    for (int i = 0; i < PROBE_BARS; ++i) xcd_barrier(bar);
#endif
    if (IN(1)) ph_norm1_2(P, lds);
    SEAM(1);
    if (IN(2)) ph_inproj_fast(P, lds_raw);
    SEAM(2);
    if (IN(3)) { ph_compress_fast(P, lds_raw); ph_bias13_gemm(P, lds_raw); ph_conv2(P, lds, CW_CONVQ, 0u, CONV_P3); xcd_barrier(bar); ph_compress2b(P, lds_raw); }
    SEAM(3);
    if (IN(4)) { fa::attn_phase(P, lds_raw); ph_conv2(P, lds, CW_CONVQ2, CONV_P3, MTOK / 64); }
    SEAM(4);
    if (IN(5)) ph_outproj_fast(P, lds_raw);
    const bool g4 = gridDim.x == 256 && IN(4) && IN(7);
    bool same_xcd = false; unsigned* g4cnt = nullptr;
    if (g4) {
        const int x8 = blockIdx.x & 7, p8 = (blockIdx.x >> 3) & 7;
        const unsigned* tab = (const unsigned*)(P.ws + WS_XCCTAB);
        const unsigned i0 = tab[x8 + 8 * p8], i1 = tab[x8 + 8 * (p8 + 8)], i2 = tab[x8 + 8 * (p8 + 16)], i3 = tab[x8 + 8 * (p8 + 24)];
        same_xcd = (i0 == i1) && (i0 == i2) && (i0 == i3);
        g4cnt = (unsigned*)(P.ws + WS_CTL) + CW_GRP4 + (x8 * 8 + p8) * 32;
    }
    if (g4) grp4_sync(g4cnt, same_xcd, bar.bar); else SEAM(5);
    if (IN(6)) ph_ffn1_fast(P, lds_raw);
    if (g4) grp4_sync(g4cnt + 16, same_xcd, bar.bar); else SEAM(6);
    if (IN(7)) ph_ffn2_fast(P, lds_raw);
#undef IN
#undef SEAM
}

#ifndef N_LAUNCHES
#define N_LAUNCHES 1
#endif
extern "C" void kernel_launch(void* const* d_in, const int* in_sizes, int n_in, void* d_out, int out_size, void* d_ws, size_t ws_size, hipStream_t stream) {
    static int grid = 0;
    if (grid == 0) {
        if (n_in != 25 || out_size != MTOK * DM || ws_size < WS_END) { fprintf(stderr, "kernel_launch: unexpected shapes n_in %d out %d ws %zu\n", n_in, out_size, ws_size); grid = -1; return; }
        int dev = 0, cus = 0, per_cu = 0;
        if (hipGetDevice(&dev) != hipSuccess || hipDeviceGetAttribute(&cus, hipDeviceAttributeMultiprocessorCount, dev) != hipSuccess) { grid = -1; return; }
        if (hipFuncSetAttribute((const void*)mega_fwd, hipFuncAttributeMaxDynamicSharedMemorySize, LDS_BYTES) != hipSuccess) { fprintf(stderr, "kernel_launch: hipFuncSetAttribute failed\n"); grid = -1; return; }
        if (hipOccupancyMaxActiveBlocksPerMultiprocessor(&per_cu, (const void*)mega_fwd, 512, LDS_BYTES) != hipSuccess || per_cu < 1) { fprintf(stderr, "kernel_launch: occupancy query says %d\n", per_cu); per_cu = 1; }
        (void)hipGetLastError();
        grid = cus;
    }
    if (grid < 0) return;
    (void)hipMemsetAsync((char*)d_ws + WS_CTL, 0, CTL_ZERO_BYTES, stream);
    Args a{};
    const float** pp = (const float**)&a.P;
    for (int i = 0; i < 25; ++i) pp[i] = (const float*)d_in[i];
    a.P.out = (float*)d_out;
    a.P.ws = (unsigned char*)d_ws;
#ifdef PROBE_TWICE
    { a.li = 0; a.ph_lo = 0; a.ph_hi = 8; hipLaunchKernelGGL(mega_fwd, dim3(grid), dim3(512), LDS_BYTES, stream, a);
      (void)hipMemsetAsync((char*)d_ws + WS_CTL, 0, 4096, stream);
      a.li = 1; hipLaunchKernelGGL(mega_fwd, dim3(grid), dim3(512), LDS_BYTES, stream, a); return; }
#endif
#ifdef PROBE_PH
    { const int k = PROBE_PH;
      a.ph_lo = 0; a.ph_hi = k + 1; hipLaunchKernelGGL(mega_fwd, dim3(grid), dim3(512), LDS_BYTES, stream, a);
      a.li = 1; a.ph_lo = k; a.ph_hi = k + 1; hipLaunchKernelGGL(mega_fwd, dim3(grid), dim3(512), LDS_BYTES, stream, a);
      a.li = 2; a.ph_lo = k + 1; a.ph_hi = 8; if (k + 1 < 8) hipLaunchKernelGGL(mega_fwd, dim3(grid), dim3(512), LDS_BYTES, stream, a); return; }
#endif
    if (N_LAUNCHES == 1) { a.ph_lo = 0; a.ph_hi = 8; hipLaunchKernelGGL(mega_fwd, dim3(grid), dim3(512), LDS_BYTES, stream, a); }
    else for (int ph = 0; ph < 8; ++ph) { a.ph_lo = ph; a.ph_hi = ph + 1; hipLaunchKernelGGL(mega_fwd, dim3(grid), dim3(512), LDS_BYTES, stream, a); }
}
```
